# Optimizing an MI355X kernel written in HIP

```python
import jax
import jax.numpy as jnp
from jax import lax
import numpy as np


D_MODEL = 1024
BATCH = 8
SEQ = 8192
DEPTH = 1

GRID_W = 64
CTX_LEN = 256
D_MIX = D_MODEL
GLA_WIDTH = D_MIX // 2
GLA_HEADS = 4
GLA_DV = GLA_WIDTH // GLA_HEADS
GLA_DK = GLA_DV // 2
GLA_QK = GLA_HEADS * GLA_DK
GLA_LOWRANK = 16
GLA_TAU = 16.0
GLA_CHUNK = 64
SC_WIDTH = D_MIX - GLA_WIDTH
D_FF = 2816
EPS = 1e-6

COL_K = 0
COL_V = COL_K + GLA_QK
COL_AF = COL_V + GLA_WIDTH
COL_AB = COL_AF + GLA_LOWRANK
COL_Q = COL_AB + GLA_LOWRANK
COL_OG = COL_Q + GLA_QK
COL_SB = COL_OG + GLA_WIDTH
COL_SC = COL_SB + SC_WIDTH
COL_SX = COL_SC + SC_WIDTH
D_IN = COL_SX + SC_WIDTH

kernel_name = "hybrid_gla_shortconv_dit_layer"


def rmsnorm(x, g):
    xf = x.astype(jnp.float32)
    y = xf * lax.rsqrt(jnp.mean(xf * xf, axis=-1, keepdims=True) + EPS)
    return (y * g.astype(jnp.float32)).astype(x.dtype)


def adaln(cond, w, b):
    return jax.nn.silu(cond) @ w + b


def modulate(h, shift, scale):
    return h * (1.0 + scale) + shift


def flip(a):
    return a[:, ::-1]


def gate_logdecay(a_low, w, b):
    a = (a_low @ w + b).astype(jnp.float32)
    return (jax.nn.log_sigmoid(a) / GLA_TAU).reshape(a.shape[0], a.shape[1], GLA_HEADS, GLA_DK)


def gla_inputs(p, w_af, b_af, w_ab, b_ab):
    bsz, t, _ = p.shape
    k = p[..., COL_K:COL_V].reshape(bsz, t, GLA_HEADS, GLA_DK)
    v = p[..., COL_V:COL_AF].reshape(bsz, t, GLA_HEADS, GLA_DV)
    g_f = gate_logdecay(p[..., COL_AF:COL_AB], w_af, b_af)
    g_b = gate_logdecay(p[..., COL_AB:COL_Q], w_ab, b_ab)
    return k, v, g_f, g_b


def gla_final_state(k, v, g):
    b = jnp.cumsum(g.astype(jnp.float32), axis=1)
    w = jnp.exp(b[:, -1:] - b)
    return jnp.einsum('bthk,bthv->bhkv', k.astype(jnp.float32) * w, v.astype(jnp.float32))


def gla_chunked(q, k, v, g, s0, strict):
    bsz, t, h, dk = q.shape
    dv = v.shape[-1]
    n = t // GLA_CHUNK

    def chunks(a):
        a = a.astype(jnp.float32).reshape(bsz, n, GLA_CHUNK, h, a.shape[-1])
        return jnp.moveaxis(a, 1, 0)

    pos = jnp.arange(GLA_CHUNK)
    mask = (pos[None, :] < pos[:, None]) if strict else (pos[None, :] <= pos[:, None])
    mask = mask[None, :, :, None, None]

    def step(s, inp):
        qc, kc, vc, gc = inp
        b = jnp.cumsum(gc, axis=1)
        o_inter = jnp.einsum('bihk,bhkv->bihv', qc * jnp.exp(b), s)
        decay = jnp.exp(jnp.where(mask, b[:, :, None] - b[:, None, :], -jnp.inf))
        att = jnp.einsum('bihk,bjhk,bijhk->bijh', qc, kc, decay)
        o_intra = jnp.einsum('bijh,bjhv->bihv', att, vc)
        b_last = b[:, -1]
        s_new = s * jnp.exp(b_last)[..., None] + jnp.einsum('bjhk,bjhv->bhkv', kc * jnp.exp(b_last[:, None] - b), vc)
        return s_new, o_inter + o_intra

    _, o = lax.scan(step, s0.astype(jnp.float32), (chunks(q), chunks(k), chunks(v), chunks(g)))
    return jnp.moveaxis(o, 0, 1).reshape(bsz, t, h, dv).astype(v.dtype)


def dwconv_row(u, w, b, rows, width):
    bsz, t, ch = u.shape
    up = jnp.pad(u.reshape(bsz, rows, width, ch), ((0, 0), (0, 0), (1, 1), (0, 0)))
    y = w[0] * up[:, :, :-2] + w[1] * up[:, :, 1:-1] + w[2] * up[:, :, 2:] + b
    return y.reshape(bsz, t, ch)


def dwconv_grid(u, w, b, rows, width):
    bsz, t, ch = u.shape
    up = jnp.pad(u.reshape(bsz, rows, width, ch), ((0, 0), (1, 1), (1, 1), (0, 0)))
    y = b
    for dr in range(3):
        for dc in range(3):
            y = y + w[dr, dc] * up[:, dr:dr + rows, dc:dc + width]
    return y.reshape(bsz, t, ch)


def token_mixers(p, s_f, s_b, rows, width, w_af, b_af, w_ab, b_ab, g_head, w_sc, b_sc):
    bsz, t, _ = p.shape
    k, v, g_f, g_b = gla_inputs(p, w_af, b_af, w_ab, b_ab)
    q = p[..., COL_Q:COL_OG].reshape(bsz, t, GLA_HEADS, GLA_DK) * (GLA_DK ** -0.5)
    og = p[..., COL_OG:COL_SB]
    o_f = gla_chunked(q, k, v, g_f, s_f, False)
    o_b = flip(gla_chunked(flip(q), flip(k), flip(v), flip(g_b), s_b, True))
    o_gla = rmsnorm(o_f + o_b, g_head).reshape(bsz, t, GLA_WIDTH) * jax.nn.silu(og)
    sb = p[..., COL_SB:COL_SC]
    sc = p[..., COL_SC:COL_SX]
    sx = p[..., COL_SX:D_IN]
    o_sc = sb * dwconv_row(sc * sx, w_sc, b_sc, rows, width)
    return jnp.concatenate([o_gla, o_sc], axis=-1)


def conv_ffn(h, rows, width, w_up, w_cf, b_cf, w_down):
    u, gate = jnp.split(h @ w_up, 2, axis=-1)
    u = dwconv_grid(u, w_cf, b_cf, rows, width)
    return (jax.nn.silu(u) * gate) @ w_down


def setup_inputs(seed: int = 0) -> dict:
    key = jax.random.key(seed)
    ks = jax.random.split(key, 24)

    def nrm(k, shape, s):
        return jax.random.normal(k, shape, jnp.float32) * s

    L = DEPTH
    return {
        'x': nrm(ks[0], (BATCH, SEQ, D_MODEL), 1.0),
        'c': nrm(ks[1], (BATCH, D_MODEL), 1.0),
        'ctx': nrm(ks[2], (BATCH, CTX_LEN, D_MODEL), 1.0),
        'c_ctx': nrm(ks[3], (D_MODEL,), 1.0),
        'w_ada': nrm(ks[4], (L, D_MODEL, 6 * D_MODEL), D_MODEL ** -0.5),
        'b_ada': nrm(ks[5], (L, 6 * D_MODEL), 0.01),
        'g_pre_mix': 1.0 + nrm(ks[6], (L, D_MODEL), 0.05),
        'g_post_mix': 1.0 + nrm(ks[7], (L, D_MODEL), 0.05),
        'g_pre_ffn': 1.0 + nrm(ks[8], (L, D_MODEL), 0.05),
        'g_post_ffn': 1.0 + nrm(ks[9], (L, D_MODEL), 0.05),
        'w_in': nrm(ks[10], (L, D_MODEL, D_IN), D_MODEL ** -0.5),
        'w_af': nrm(ks[11], (L, GLA_LOWRANK, GLA_QK), GLA_LOWRANK ** -0.5),
        'b_af': nrm(ks[12], (L, GLA_QK), 0.1),
        'w_ab': nrm(ks[13], (L, GLA_LOWRANK, GLA_QK), GLA_LOWRANK ** -0.5),
        'b_ab': nrm(ks[14], (L, GLA_QK), 0.1),
        'g_head': 1.0 + nrm(ks[15], (L, GLA_DV), 0.05),
        'w_sc': nrm(ks[16], (L, 3, SC_WIDTH), 0.5),
        'b_sc': nrm(ks[17], (L, SC_WIDTH), 0.01),
        'w_out': nrm(ks[18], (L, D_MIX, D_MODEL), D_MIX ** -0.5),
        'w_up': nrm(ks[19], (L, D_MODEL, 2 * D_FF), D_MODEL ** -0.5),
        'w_cf': nrm(ks[20], (L, 3, 3, D_FF), 1.0 / 3.0),
        'b_cf': nrm(ks[21], (L, D_FF), 0.01),
        'w_down': nrm(ks[22], (L, D_FF, D_MODEL), D_FF ** -0.5),
    }


def reference(x, c, ctx, c_ctx, w_ada, b_ada, g_pre_mix, g_post_mix, g_pre_ffn, g_post_ffn,
              w_in, w_af, b_af, w_ab, b_ab, g_head, w_sc, b_sc, w_out, w_up, w_cf, b_cf, w_down):
    rows = x.shape[1] // GRID_W
    ctx_len = ctx.shape[1]
    for i in range(DEPTH):
        update_ctx = i + 1 < DEPTH
        sh1, sc1, gt1, sh2, sc2, gt2 = jnp.split(adaln(c, w_ada[i], b_ada[i])[:, None, :], 6, axis=-1)
        csh1, csc1, cgt1, csh2, csc2, cgt2 = jnp.split(adaln(c_ctx, w_ada[i], b_ada[i]), 6, axis=-1)
        gla_p = (w_af[i], b_af[i], w_ab[i], b_ab[i])

        hc = modulate(rmsnorm(ctx, g_pre_mix[i]), csh1, csc1)
        pc = hc @ (w_in[i] if update_ctx else w_in[i][:, :COL_Q])
        kc, vc, gfc, gbc = gla_inputs(pc, *gla_p)
        s_f = gla_final_state(kc, vc, gfc)
        s_b = gla_final_state(flip(kc), flip(vc), flip(gbc))

        hx = modulate(rmsnorm(x, g_pre_mix[i]), sh1, sc1)
        yx = token_mixers(hx @ w_in[i], s_f, s_b, rows, GRID_W, *gla_p, g_head[i], w_sc[i], b_sc[i])
        x = x + gt1 * rmsnorm(yx @ w_out[i], g_post_mix[i])

        hx = modulate(rmsnorm(x, g_pre_ffn[i]), sh2, sc2)
        x = x + gt2 * rmsnorm(conv_ffn(hx, rows, GRID_W, w_up[i], w_cf[i], b_cf[i], w_down[i]), g_post_ffn[i])

        if update_ctx:
            zero_state = jnp.zeros_like(s_f)
            yc = token_mixers(pc, zero_state, zero_state, 1, ctx_len, *gla_p, g_head[i], w_sc[i], b_sc[i])
            ctx = ctx + cgt1 * rmsnorm(yc @ w_out[i], g_post_mix[i])
            hc = modulate(rmsnorm(ctx, g_pre_ffn[i]), csh2, csc2)
            ctx = ctx + cgt2 * rmsnorm(conv_ffn(hc, 1, ctx_len, w_up[i], w_cf[i], b_cf[i], w_down[i]), g_post_ffn[i])
    return x
```

```cpp
#include <hip/hip_runtime.h>
#include <hip/hip_cooperative_groups.h>
#include <cstdio>
#include <cstdint>
namespace pg8 {
#define PG8_LAS __attribute__((address_space(3)))
typedef unsigned short bf16_t;
typedef short bf16x8 __attribute__((ext_vector_type(8)));
typedef float f32x4 __attribute__((ext_vector_type(4)));
typedef unsigned u32x4 __attribute__((ext_vector_type(4)));
constexpr int BM = 256, BK = 64, HALF = 128, HTB = HALF * BK * 2  , STAGE_BYTES = 8 * HTB, NXCD = 8, WGM = 4;

__host__ __device__ __forceinline__ int lds_byte(int r, int c) { const int st = (r >> 4) * 2 + (c >> 5), rr = r & 15, cc = c & 31, ob = rr * 64 + cc * 2; return st * 1024 + (ob ^ (((ob >> 9) & 1) << 5)); }
__host__ __device__ __forceinline__ void stage_rc(int b, int& R, int& C) { const int st = b / 1024, sb = b % 1024, swz = sb ^ (((sb >> 9) & 1) << 5); R = (st >> 1) * 16 + swz / 64; C = (st & 1) * 32 + (swz % 64) / 2; }
__host__ __device__ __forceinline__ int perm32(int rho) { const int n = rho >> 4, i = rho & 15; return 8 * (i >> 2) + 4 * n + (i & 3); }

struct Unit { int pm, pn; };
struct Gemm { const bf16_t* A; const bf16_t* Bt; int M, N, K; };

struct StaticOrder {
    int nM, nN, nwg, G, c;
    __host__ __device__ void init(int M, int N, int G_, int c_) { nM = M / BM; nN = N / BM; nwg = nM * nN; G = G_; c = c_; }
    __host__ __device__ bool next(int i, Unit& u) const {
        const long L = (long)i * G + c; if (L >= nwg) return false;
        int wgid = (int)L; { const int q = nwg / NXCD, r = nwg % NXCD, xcd = wgid % NXCD, off = wgid / NXCD; wgid = (xcd < r ? xcd * (q + 1) : r * (q + 1) + (xcd - r) * q) + off; }
        const int nig = WGM * nN, gid = wgid / nig, fm = gid * WGM, gsz = (nM - fm) < WGM ? (nM - fm) : WGM;
        u.pm = fm + ((wgid % nig) % gsz); u.pn = (wgid % nig) / gsz; return true;
    }
    __device__ __forceinline__ void a_ready(const Unit&) const {}
    __device__ __forceinline__ void done(const Unit&) const {}
};

typedef float f32x2c_t __attribute__((ext_vector_type(2))); typedef __bf16 bf16x2c_t __attribute__((ext_vector_type(2)));
__device__ __forceinline__ unsigned cvt_pk_bf16(float lo, float hi) { f32x2c_t v = {lo, hi}; bf16x2c_t b = __builtin_convertvector(v, bf16x2c_t); return __builtin_bit_cast(unsigned, b); }
struct EpiStore {
    static constexpr bool PERM = true, AFTER_DRAIN = false;
    bf16_t* O; int ldc; int split_cols; size_t split_stride;
    __device__ __forceinline__ void operator()(const f32x4 (&acc)[2][2][4][2], const Unit& u, int wr, int wc, int fr, int fq) const {
        const int row0 = u.pm * BM + wr * 64 + fr; int colt = u.pn * BM; bf16_t* base = O;
        if (split_cols) { const int t = colt / split_cols; base += (size_t)t * split_stride; colt -= t * split_cols; }
        const int col0 = colt + wc * 32 + 8 * fq;
#pragma unroll
        for (int ai = 0; ai < 2; ++ai)
#pragma unroll
            for (int m = 0; m < 4; ++m) { bf16_t* rowp = base + (size_t)(row0 + ai * HALF + m * 16) * ldc + col0;
#pragma unroll
                for (int bj = 0; bj < 2; ++bj) { const f32x4 v0 = acc[ai][bj][m][0], v1 = acc[ai][bj][m][1];
                    u32x4 w; w.x = cvt_pk_bf16(v0[0], v0[1]); w.y = cvt_pk_bf16(v0[2], v0[3]); w.z = cvt_pk_bf16(v1[0], v1[1]); w.w = cvt_pk_bf16(v1[2], v1[3]);
                    *(u32x4*)(rowp + bj * HALF) = w; } }
    }
};
template <class Epi, class Sched, bool ALIGN_EPI = false, bool SP2 = false>
__device__ __forceinline__ void gemm_phase(PG8_LAS unsigned char* lds, const Gemm g, const Sched& S, const Epi& E) {
    int tid_l = threadIdx.x; asm volatile("" : "+v"(tid_l));
    const int tid = tid_l, wid = __builtin_amdgcn_readfirstlane(tid >> 6), lane = tid & 63, wr = wid >> 2, wc = wid & 3, fr = lane & 15, fq = lane >> 4;
    const int K = g.K, nt = K / BK;
    unsigned voffA[2], voffB[2];
#pragma unroll
    for (int i = 0; i < 2; ++i) { int R, C; stage_rc(tid * 16 + i * 8192, R, C); const int Rb = Epi::PERM ? ((R & ~31) + perm32(R & 31)) : R;
        voffA[i] = (unsigned)(R * K + C) * 2u; voffB[i] = (unsigned)(Rb * K + C) * 2u; }
    const size_t kstep = (size_t)(BK * 2);
    const size_t hstep = (size_t)HALF * K * 2;
    const size_t tstep = 2 * hstep;
    const unsigned ldsw = (unsigned)wid * 1024u;
    const int aoff = lds_byte(wr * 64 + fr, fq * 8), boff = lds_byte(wc * 32 + fr, fq * 8);
#define PG8_SA(b, h) (((b) * 2 + (h)) * HTB)
#define PG8_SB(b, h) ((4 + (b) * 2 + (h)) * HTB)
#define PG8_STAGE(bufoff, gbase, voff) do { _Pragma("unroll") for (int _i = 0; _i < 2; ++_i) \
        __builtin_amdgcn_global_load_lds((const unsigned*)((const char*)(gbase) + (voff)[_i]), (PG8_LAS unsigned*)(lds + (bufoff) + ldsw + _i * 8192), 16, 0, 0); } while (0)
#define PG8_LDA(dst, b, h) do { _Pragma("unroll") for (int m = 0; m < 4; ++m) _Pragma("unroll") for (int k = 0; k < 2; ++k) dst[m][k] = *(const PG8_LAS bf16x8*)(lds + PG8_SA(b, h) + aoff + m * 2048 + k * 1024); } while (0)
#define PG8_LDB(dst, b, h) do { _Pragma("unroll") for (int n = 0; n < 2; ++n) _Pragma("unroll") for (int k = 0; k < 2; ++k) dst[n][k] = *(const PG8_LAS bf16x8*)(lds + PG8_SB(b, h) + boff + n * 2048 + k * 1024); } while (0)
#define PG8_MMA(ai, bj, At, Bt) do { __builtin_amdgcn_s_setprio(1); _Pragma("unroll") for (int m = 0; m < 4; ++m) _Pragma("unroll") for (int n = 0; n < 2; ++n) _Pragma("unroll") for (int k = 0; k < 2; ++k) \
        acc[ai][bj][m][n] = __builtin_amdgcn_mfma_f32_16x16x32_bf16(Bt[n][k], At[m][k], acc[ai][bj][m][n], 0, 0, 0); __builtin_amdgcn_s_setprio(0); } while (0)
#define PG8_WAIT_V(n) asm volatile("s_waitcnt vmcnt(" #n ")" ::: "memory")
#define PG8_WAIT_L(n) asm volatile("s_waitcnt lgkmcnt(" #n ")" ::: "memory")
#define PG8_BAR __builtin_amdgcn_s_barrier()
#define PG8_SCHED __builtin_amdgcn_sched_barrier(0)
    Unit cur, nxt; int ui = 0;
    if (!S.next(0, cur)) return;
    f32x4 acc[2][2][4][2];
#pragma unroll
    for (int a = 0; a < 2; ++a)
#pragma unroll
        for (int b = 0; b < 2; ++b)
#pragma unroll
            for (int m = 0; m < 4; ++m)
#pragma unroll
                for (int n = 0; n < 2; ++n) acc[a][b][m][n] = (f32x4){0.f, 0.f, 0.f, 0.f};
    bf16x8 At[4][2], B0[2][2], B1[2][2];
    const char* cA = (const char*)g.A + (size_t)cur.pm * tstep; const char* cB = (const char*)g.Bt + (size_t)cur.pn * tstep;
    S.a_ready(cur);
    if constexpr (SP2) {
        PG8_STAGE(PG8_SB(0, 0), cB, voffB); PG8_STAGE(PG8_SB(0, 1), cB + hstep, voffB); PG8_STAGE(PG8_SA(0, 0), cA, voffA); PG8_STAGE(PG8_SA(0, 1), cA + hstep, voffA);
        if (wr == 1) PG8_BAR;
        PG8_WAIT_V(2); PG8_BAR;
        PG8_STAGE(PG8_SB(1, 0), cB + kstep, voffB); PG8_STAGE(PG8_SA(1, 0), cA + kstep, voffA); PG8_STAGE(PG8_SB(1, 1), cB + hstep + kstep, voffB);
        PG8_WAIT_V(6); PG8_BAR;
    } else {
        PG8_STAGE(PG8_SB(0, 0), cB, voffB); PG8_STAGE(PG8_SA(0, 0), cA, voffA); PG8_STAGE(PG8_SB(0, 1), cB + hstep, voffB); PG8_STAGE(PG8_SA(0, 1), cA + hstep, voffA);
        if (wr == 1) PG8_BAR;
        PG8_WAIT_V(4); PG8_BAR;
        PG8_STAGE(PG8_SB(1, 0), cB + kstep, voffB); PG8_STAGE(PG8_SA(1, 0), cA + kstep, voffA); PG8_STAGE(PG8_SB(1, 1), cB + hstep + kstep, voffB);
        PG8_WAIT_V(6); PG8_BAR;
    }
    for (;;) {
        const bool has_next = S.next(ui + 1, nxt);
        const char* nA = has_next ? (const char*)g.A + (size_t)nxt.pm * tstep : cA; const char* nB = has_next ? (const char*)g.Bt + (size_t)nxt.pn * tstep : cB;
        for (int t = 0; t < nt; t += 2) {
            const bool last = (t == nt - 2);
            const char* a1 = cA + (size_t)(t + 1) * kstep;
            const char* a2 = last ? nA : cA + (size_t)(t + 2) * kstep; const char* b2 = last ? nB : cB + (size_t)(t + 2) * kstep;
            const char* a3 = a2 + kstep; const char* b3 = b2 + kstep;
            if (last && has_next) S.a_ready(nxt);
            if constexpr (SP2) {
            PG8_LDB(B0, 0, 0); PG8_LDB(B1, 0, 1); PG8_SCHED; PG8_LDA(At, 0, 0); PG8_STAGE(PG8_SA(1, 1), a1 + hstep, voffA);
            PG8_WAIT_V(8); PG8_WAIT_L(0); PG8_BAR; PG8_MMA(0, 0, At, B0); PG8_MMA(0, 1, At, B1); PG8_BAR; PG8_SCHED;
            PG8_LDA(At, 0, 1); PG8_STAGE(PG8_SB(0, 0), b2, voffB); PG8_STAGE(PG8_SB(0, 1), b2 + hstep, voffB); PG8_STAGE(PG8_SA(0, 0), a2, voffA);
            PG8_WAIT_V(8); PG8_WAIT_L(0); PG8_BAR; PG8_MMA(1, 0, At, B0); PG8_MMA(1, 1, At, B1); PG8_BAR; PG8_SCHED;
            PG8_LDB(B0, 1, 0); PG8_LDB(B1, 1, 1); PG8_SCHED; PG8_LDA(At, 1, 0); PG8_STAGE(PG8_SA(0, 1), a2 + hstep, voffA);
            PG8_WAIT_V(8); PG8_WAIT_L(0); PG8_BAR; PG8_MMA(0, 0, At, B0); PG8_MMA(0, 1, At, B1); PG8_BAR; PG8_SCHED;
            PG8_LDA(At, 1, 1); PG8_STAGE(PG8_SB(1, 0), b3, voffB); PG8_STAGE(PG8_SB(1, 1), b3 + hstep, voffB); PG8_STAGE(PG8_SA(1, 0), a3, voffA);
            PG8_WAIT_V(8); PG8_WAIT_L(0); PG8_BAR; PG8_MMA(1, 0, At, B0); PG8_MMA(1, 1, At, B1); PG8_BAR; PG8_SCHED;
            } else {
            PG8_LDB(B0, 0, 0); PG8_SCHED; PG8_LDA(At, 0, 0); PG8_STAGE(PG8_SA(1, 1), a1 + hstep, voffA);
            PG8_WAIT_L(8); PG8_BAR; PG8_WAIT_L(0); PG8_MMA(0, 0, At, B0); PG8_BAR; PG8_SCHED;
            PG8_LDB(B1, 0, 1); PG8_STAGE(PG8_SB(0, 0), b2, voffB);
            PG8_BAR; PG8_WAIT_L(0); PG8_MMA(0, 1, At, B1); PG8_BAR;
            PG8_LDA(At, 0, 1); PG8_STAGE(PG8_SA(0, 0), a2, voffA);
            PG8_BAR; PG8_WAIT_L(0); PG8_MMA(1, 0, At, B0); PG8_BAR; PG8_SCHED;
            PG8_STAGE(PG8_SB(0, 1), b2 + hstep, voffB);
            PG8_WAIT_V(6); PG8_BAR; PG8_MMA(1, 1, At, B1); PG8_BAR;
            PG8_LDB(B0, 1, 0); PG8_SCHED; PG8_LDA(At, 1, 0); PG8_STAGE(PG8_SA(0, 1), a2 + hstep, voffA);
            PG8_WAIT_L(8); PG8_BAR; PG8_WAIT_L(0); PG8_MMA(0, 0, At, B0); PG8_BAR; PG8_SCHED;
            PG8_LDB(B1, 1, 1); PG8_STAGE(PG8_SB(1, 0), b3, voffB);
            PG8_BAR; PG8_WAIT_L(0); PG8_MMA(0, 1, At, B1); PG8_BAR;
            PG8_LDA(At, 1, 1); PG8_STAGE(PG8_SA(1, 0), a3, voffA);
            PG8_BAR; PG8_WAIT_L(0); PG8_MMA(1, 0, At, B0); PG8_BAR; PG8_SCHED;
            PG8_STAGE(PG8_SB(1, 1), b3 + hstep, voffB);
            PG8_WAIT_V(6); PG8_BAR; PG8_MMA(1, 1, At, B1); PG8_BAR;
            }
        }
        if constexpr (ALIGN_EPI) { if (wr == 0) PG8_BAR; }
        if constexpr (!Epi::AFTER_DRAIN) { E(acc, cur, wr, wc, fr, fq); S.done(cur); }
        if (!has_next) break;
#pragma unroll
        for (int a = 0; a < 2; ++a)
#pragma unroll
            for (int b = 0; b < 2; ++b)
#pragma unroll
                for (int m = 0; m < 4; ++m)
#pragma unroll
                    for (int n = 0; n < 2; ++n) acc[a][b][m][n] = (f32x4){0.f, 0.f, 0.f, 0.f};
        cur = nxt; cA = nA; cB = nB; ++ui;
        if constexpr (ALIGN_EPI) { if (wr == 1) PG8_BAR; }
    }
    PG8_WAIT_V(0);
    if constexpr (!ALIGN_EPI) { if (wr == 0) PG8_BAR; }
    PG8_BAR;
    if constexpr (Epi::AFTER_DRAIN) { E.fused(acc, cur, wr, wc, fr, fq, lds, wid, lane); S.done(cur); }
#undef PG8_SA
#undef PG8_SB
#undef PG8_STAGE
#undef PG8_LDA
#undef PG8_LDB
#undef PG8_MMA
#undef PG8_WAIT_V
#undef PG8_WAIT_L
#undef PG8_BAR
#undef PG8_SCHED
}
}

namespace cg = cooperative_groups;
#define GRID_SYNC() do { asm volatile("s_waitcnt vmcnt(0)" ::: "memory"); grid.sync(); __builtin_amdgcn_fence(__ATOMIC_ACQUIRE, "agent"); asm volatile("s_waitcnt vmcnt(0)" ::: "memory"); } while (0)
#define LAS __attribute__((address_space(3)))
typedef unsigned short bf16;
typedef float f32x4 __attribute__((ext_vector_type(4)));
typedef short bf16x8 __attribute__((ext_vector_type(8)));
typedef short s16x4 __attribute__((ext_vector_type(4)));
typedef unsigned v4u __attribute__((ext_vector_type(4)));
typedef unsigned v2u __attribute__((ext_vector_type(2)));
typedef float f32x2 __attribute__((ext_vector_type(2)));

constexpr int D = 1024, NB = 8, T = 8192, NTOK = NB * T, CTXL = 256, NCTX = NB * CTXL, MROWS = NTOK + NCTX;
constexpr int DIN = 3104, DINP = 3328, DFF = 2816;
constexpr int COL_K = 0, COL_V = 256, COL_AF = 768, COL_AB = 784, COL_Q = 800, COL_OG = 1056, COL_SB = 1568, COL_SC = 2080, COL_SX = 2592;
constexpr int PC_AL = 0, PC_HEAD = 32, PC_HSTRIDE = 384, PC_K = 0, PC_V = 64, PC_Q = 192, PC_OG = 256;
__host__ __device__ constexpr int pcol32(int n0) {
    return n0 < COL_V ? PC_HEAD + (n0 / 64) * PC_HSTRIDE + PC_K + n0 % 64
         : n0 < COL_AF ? PC_HEAD + ((n0 - COL_V) / 128) * PC_HSTRIDE + PC_V + (n0 - COL_V) % 128
         : n0 < COL_Q ? PC_AL
         : n0 < COL_OG ? PC_HEAD + ((n0 - COL_Q) / 64) * PC_HSTRIDE + PC_Q + (n0 - COL_Q) % 64
         : n0 < COL_SB ? PC_HEAD + ((n0 - COL_OG) / 128) * PC_HSTRIDE + PC_OG + (n0 - COL_OG) % 128
         : n0;
}
constexpr int NCH = 132;
constexpr float EPS = 1e-6f;
constexpr int NTHR = 512, LDS_STAGE = 131072, LDS_BYTES = LDS_STAGE + 64;

constexpr size_t WS_MOD  = 0;
constexpr size_t WS_BAR  = 229376;
constexpr size_t WS_DEC  = 262144;
constexpr size_t WS_WIN  = WS_DEC + (size_t)NB * 2 * 4 * NCH * 64 * 4 + 0;
constexpr size_t WS_WOUT = WS_WIN + (size_t)DINP * D * 2;
constexpr size_t WS_WUP  = WS_WOUT + (size_t)D * D * 2;
constexpr size_t WS_WDN  = WS_WUP + (size_t)2 * DFF * D * 2;
constexpr size_t WS_A    = WS_WDN + (size_t)D * DFF * 2;
constexpr size_t WS_B    = WS_A + (size_t)MROWS * D * 2;
constexpr size_t WS_ST   = WS_B + (size_t)MROWS * DINP * 2;
constexpr size_t WS_UG   = WS_B + (size_t)NTOK * DFF * 2;
constexpr size_t WS_X1   = WS_B + (size_t)2 * NTOK * DFF * 2;
constexpr size_t WS_END  = WS_X1 + (size_t)NTOK * D * 2;
static_assert(WS_ST + (size_t)NB * 2 * 4 * NCH * 8192 * 2 <= WS_X1, "state buffer must fit under U");
static_assert(WS_WIN % 256 == 0 && WS_A % 256 == 0 && WS_B % 256 == 0 && WS_ST % 256 == 0, "alignment");

struct Args { const float* in[23]; float* out; unsigned char* ws; };

__device__ __forceinline__ float bf2f(unsigned v) { return __uint_as_float(v << 16); }
__device__ __forceinline__ unsigned pk2(float lo, float hi) { return pg8::cvt_pk_bf16(lo, hi); }
__device__ __forceinline__ bf16 f2bf(float v) { return (bf16)(pk2(v, 0.f) & 0xffffu); }
__device__ __forceinline__ float wave_sum(float v) {
#pragma unroll
    for (int o = 1; o < 64; o <<= 1) v += __shfl_xor(v, o);
    return v;
}
#define LDS_WAIT() asm volatile("s_waitcnt lgkmcnt(0)" ::: "memory")
__device__ __forceinline__ float fexp2(float x) { return __builtin_amdgcn_exp2f(x); }
__device__ __forceinline__ float logsig2(float a) { const float t = a * 1.44269504f; return fminf(t, 0.f) - __builtin_amdgcn_logf(1.f + fexp2(-fabsf(t))); }
__device__ __forceinline__ float silu(float a) { return a * __builtin_amdgcn_rcpf(1.f + fexp2(a * -1.44269504f)); }

__device__ __forceinline__ bf16x8 frag_row(const LAS bf16* base, int stride, int r0, int k0, int lane) {
    return *(const LAS bf16x8*)(base + (r0 + (lane & 15)) * stride + k0 + 8 * (lane >> 4));
}
__device__ __forceinline__ bf16x8 frag_tr(const LAS bf16* base, int stride, int k0, int x0, int lane) {
    const int g = lane >> 4, q = (lane & 15) >> 2, p = lane & 3;
    const unsigned a0 = (unsigned)(uintptr_t)(base + (k0 + 8 * g + q) * stride + x0 + 4 * p);
    const unsigned a1 = a0 + (unsigned)(4 * stride * 2);
    s16x4 lo, hi;
    asm volatile("ds_read_b64_tr_b16 %0, %2\n\tds_read_b64_tr_b16 %1, %3\n\ts_waitcnt lgkmcnt(0)" : "=&v"(lo), "=&v"(hi) : "v"(a0), "v"(a1) : "memory");
    bf16x8 r; r[0] = lo[0]; r[1] = lo[1]; r[2] = lo[2]; r[3] = lo[3]; r[4] = hi[0]; r[5] = hi[1]; r[6] = hi[2]; r[7] = hi[3];
    return r;
}
__device__ __forceinline__ void frag_tr4_136(const LAS bf16* base, int k0, int x0, int lane, bf16x8 (&out)[4]) {
    const int g = lane >> 4, q = (lane & 15) >> 2, p = lane & 3;
    const unsigned a = (unsigned)(uintptr_t)(base + (k0 + 8 * g + q) * 136 + x0 + 4 * p);
    s16x4 l0, l1, l2, l3, h0, h1, h2, h3;
    asm volatile("ds_read_b64_tr_b16 %0, %8\n\tds_read_b64_tr_b16 %1, %8 offset:32\n\tds_read_b64_tr_b16 %2, %8 offset:64\n\tds_read_b64_tr_b16 %3, %8 offset:96\n\t"
                 "ds_read_b64_tr_b16 %4, %8 offset:1088\n\tds_read_b64_tr_b16 %5, %8 offset:1120\n\tds_read_b64_tr_b16 %6, %8 offset:1152\n\tds_read_b64_tr_b16 %7, %8 offset:1184\n\ts_waitcnt lgkmcnt(0)"
                 : "=&v"(l0), "=&v"(l1), "=&v"(l2), "=&v"(l3), "=&v"(h0), "=&v"(h1), "=&v"(h2), "=&v"(h3) : "v"(a) : "memory");
#define PACK8(o, l, h) o[0] = l[0]; o[1] = l[1]; o[2] = l[2]; o[3] = l[3]; o[4] = h[0]; o[5] = h[1]; o[6] = h[2]; o[7] = h[3]
    PACK8(out[0], l0, h0); PACK8(out[1], l1, h1); PACK8(out[2], l2, h2); PACK8(out[3], l3, h3);
#undef PACK8
}
#define MFMA16(a, b, c) __builtin_amdgcn_mfma_f32_16x16x32_bf16((a), (b), (c), 0, 0, 0)

template <bool PERMUTE> __device__ __forceinline__ void transpose_item(const float* W, int K, int N, bf16* WT, LAS float* scr, int item, int lane) {
    const int nblk = N / 32, kb = item / nblk, nb = item % nblk, k0 = 64 * kb, n0 = 32 * nb, n0o = PERMUTE ? pcol32(n0) : n0;
#pragma unroll 8
    for (int i = 0; i < 32; ++i) { const int kk = 2 * i + (lane >> 5); scr[kk * 33 + (lane & 31)] = W[(size_t)(k0 + kk) * N + n0 + (lane & 31)]; }
    LDS_WAIT();
    const int c = lane & 7;
#pragma unroll
    for (int j = 0; j < 4; ++j) { const int n = (lane >> 3) + 8 * j; const LAS float* s = scr + (8 * c) * 33 + n;
        v4u o; o.x = pk2(s[0 * 33], s[1 * 33]); o.y = pk2(s[2 * 33], s[3 * 33]); o.z = pk2(s[4 * 33], s[5 * 33]); o.w = pk2(s[6 * 33], s[7 * 33]);
        *(v4u*)(WT + (size_t)(n0o + n) * K + k0 + 8 * c) = o; }
    LDS_WAIT();
}

__device__ __forceinline__ void phase_wprep(const Args& A, LAS unsigned char* lds, int tid, int lane, int wave) {
    unsigned char* ws = A.ws;
    bf16* WinT = (bf16*)(ws + WS_WIN); bf16* WoutT = (bf16*)(ws + WS_WOUT); bf16* WupT = (bf16*)(ws + WS_WUP); bf16* WdnT = (bf16*)(ws + WS_WDN);
    const int gw = blockIdx.x * 8 + wave, NGW = gridDim.x * 8;
    LAS float* scr = (LAS float*)(lds + wave * 8448);
    constexpr int I_IN = (D / 64) * (DIN / 32), I_OUT = (D / 64) * (D / 32), I_UP = (D / 64) * (2 * DFF / 32), I_DN = (DFF / 64) * (D / 32);
    for (int it = gw; it < I_IN + I_OUT + I_UP + I_DN; it += NGW) {
        int r = it;
        if (r < I_IN) { transpose_item<true>(A.in[10], D, DIN, WinT, scr, r, lane); continue; } r -= I_IN;
        if (r < I_OUT) { transpose_item<false>(A.in[18], D, D, WoutT, scr, r, lane); continue; } r -= I_OUT;
        if (r < I_UP) { transpose_item<false>(A.in[19], D, 2 * DFF, WupT, scr, r, lane); continue; } r -= I_UP;
        transpose_item<false>(A.in[22], DFF, D, WdnT, scr, r, lane);
    }
    { const size_t n16 = (size_t)(DINP - DIN) * D * 2 / 16; v4u* z = (v4u*)(WinT + (size_t)DIN * D);
      for (size_t i = (size_t)blockIdx.x * NTHR + tid; i < n16; i += (size_t)gridDim.x * NTHR) z[i] = (v4u){0u, 0u, 0u, 0u}; }
}
__device__ __forceinline__ void phase_mod(const Args& A, LAS unsigned char* lds, int tid) {
    unsigned char* ws = A.ws;
    float* mod = (float*)(ws + WS_MOD);
    LAS float* sil = (LAS float*)lds;
    LAS float* red = (LAS float*)(lds + 9 * 1024 * 4);
    const float* w_ada = A.in[4]; const float* b_ada = A.in[5];
    bool have = false;
    for (int item = blockIdx.x; item < 6 * D / 32; item += gridDim.x) {
        if (!have) {
            for (int i = tid; i < 9 * 1024; i += NTHR) { const float v = i < 8 * 1024 ? A.in[1][i] : A.in[3][i - 8 * 1024]; sil[i] = silu(v); }
            have = true;
        }
        __syncthreads();
        const int col = tid & 31, ks = tid >> 5, n = item * 32 + col;
        float acc[9];
#pragma unroll
        for (int r = 0; r < 9; ++r) acc[r] = 0.f;
#pragma unroll 16
        for (int i = 0; i < 64; ++i) { const int k = ks * 64 + i; const float w = w_ada[(size_t)k * (6 * D) + n];
#pragma unroll
            for (int r = 0; r < 9; ++r) acc[r] += sil[r * 1024 + k] * w; }
#pragma unroll
        for (int r = 0; r < 9; ++r) red[(ks * 9 + r) * 32 + col] = acc[r];
        __syncthreads();
        if (tid < 9 * 32) { const int r = tid >> 5, c2 = tid & 31; float s = b_ada[item * 32 + c2];
#pragma unroll
            for (int k2 = 0; k2 < 16; ++k2) s += red[(k2 * 9 + r) * 32 + c2];
            mod[r * (6 * D) + item * 32 + c2] = s; }
        __syncthreads();
    }
}

__device__ __forceinline__ void store_bf16x4(bf16* p, f32x4 v) { v2u o; o.x = pk2(v[0], v[1]); o.y = pk2(v[2], v[3]); *(v2u*)p = o; }
__device__ __forceinline__ f32x4 load_bf16x4(const bf16* p) { const v2u r = *(const v2u*)p; f32x4 v; v[0] = bf2f(r.x & 0xffffu); v[1] = bf2f(r.x >> 16); v[2] = bf2f(r.y & 0xffffu); v[3] = bf2f(r.y >> 16); return v; }
__device__ __forceinline__ float sumsq4(f32x4 v) { return (v[0] * v[0] + v[1] * v[1]) + (v[2] * v[2] + v[3] * v[3]); }

__device__ __forceinline__ void phase_rows1(const Args& A, int lane, int wave) {
    const float* mod = (const float*)(A.ws + WS_MOD); bf16* HX = (bf16*)(A.ws + WS_A); const float* g = A.in[6];
    const int gw = blockIdx.x * 8 + wave, NGW = gridDim.x * 8;
    for (int r0 = gw; r0 < MROWS; r0 += 2 * NGW) {
        int rr[2]; bool ok[2]; const float* src[2]; const float* m[2]; f32x4 v[2][4]; float s[2];
#pragma unroll
        for (int u = 0; u < 2; ++u) { const int r = r0 + u * NGW; ok[u] = r < MROWS; rr[u] = ok[u] ? r : r0;
            src[u] = rr[u] < NTOK ? A.in[0] + (size_t)rr[u] * D : A.in[2] + (size_t)(rr[u] - NTOK) * D; m[u] = mod + (size_t)(rr[u] < NTOK ? (rr[u] >> 13) : 8) * (6 * D); }
#pragma unroll
        for (int u = 0; u < 2; ++u) { s[u] = 0.f;
#pragma unroll
            for (int j = 0; j < 4; ++j) v[u][j] = ((const f32x4*)src[u])[lane + 64 * j]; }
#pragma unroll
        for (int u = 0; u < 2; ++u) {
#pragma unroll
            for (int j = 0; j < 4; ++j) s[u] += sumsq4(v[u][j]);
            const float rstd = rsqrtf(wave_sum(s[u]) * (1.f / D) + EPS);
            if (ok[u]) {
#pragma unroll
                for (int j = 0; j < 4; ++j) { const int col = 4 * (lane + 64 * j);
                    const f32x4 g4 = *(const f32x4*)(g + col), sh = *(const f32x4*)(m[u] + col), sc = *(const f32x4*)(m[u] + D + col);
                    const f32x4 y = v[u][j] * rstd * g4; store_bf16x4(HX + (size_t)rr[u] * D + col, y * (sc + 1.f) + sh); } } }
    }
}
__device__ __forceinline__ void phase_rows2(const Args& A, int lane, int wave) {
    const float* mod = (const float*)(A.ws + WS_MOD); const bf16* T1 = (const bf16*)(A.ws + WS_B); bf16* HX = (bf16*)(A.ws + WS_A); bf16* X1 = (bf16*)(A.ws + WS_X1);
    const float* gpost = A.in[7]; const float* gpre = A.in[8];
    const int gw = blockIdx.x * 8 + wave, NGW = gridDim.x * 8;
    for (int r0 = gw; r0 < NTOK; r0 += 2 * NGW) {
        int rr[2]; bool ok[2]; f32x4 t[2][4], xv[2][4];
#pragma unroll
        for (int u = 0; u < 2; ++u) { const int r = r0 + u * NGW; ok[u] = r < NTOK; rr[u] = ok[u] ? r : r0;
#pragma unroll
            for (int j = 0; j < 4; ++j) { const int col = 4 * (lane + 64 * j); t[u][j] = load_bf16x4(T1 + (size_t)rr[u] * D + col); xv[u][j] = *(const f32x4*)(A.in[0] + (size_t)rr[u] * D + col); } }
#pragma unroll
        for (int u = 0; u < 2; ++u) { const float* m = mod + (size_t)(rr[u] >> 13) * (6 * D);
            float s = 0.f;
#pragma unroll
            for (int j = 0; j < 4; ++j) s += sumsq4(t[u][j]);
            const float rstd = rsqrtf(wave_sum(s) * (1.f / D) + EPS);
            float s2 = 0.f;
#pragma unroll
            for (int j = 0; j < 4; ++j) { const int col = 4 * (lane + 64 * j);
                const f32x4 g4 = *(const f32x4*)(gpost + col), gt = *(const f32x4*)(m + 2 * D + col);
                xv[u][j] = xv[u][j] + gt * (t[u][j] * rstd * g4); s2 += sumsq4(xv[u][j]);
                if (ok[u]) store_bf16x4(X1 + (size_t)rr[u] * D + col, xv[u][j]); }
            const float rstd2 = rsqrtf(wave_sum(s2) * (1.f / D) + EPS);
            if (ok[u]) {
#pragma unroll
                for (int j = 0; j < 4; ++j) { const int col = 4 * (lane + 64 * j);
                    const f32x4 g4 = *(const f32x4*)(gpre + col), sh = *(const f32x4*)(m + 3 * D + col), sc = *(const f32x4*)(m + 4 * D + col);
                    const f32x4 y = xv[u][j] * rstd2 * g4; store_bf16x4(HX + (size_t)rr[u] * D + col, y * (sc + 1.f) + sh); } } }
    }
}
__device__ __forceinline__ void phase_rows3(const Args& A, int lane, int wave) {
    const float* mod = (const float*)(A.ws + WS_MOD); const bf16* T2 = (const bf16*)(A.ws + WS_A); const bf16* X1 = (const bf16*)(A.ws + WS_X1); const float* gpost = A.in[9];
    const int gw = blockIdx.x * 8 + wave, NGW = gridDim.x * 8;
    for (int r0 = gw; r0 < NTOK; r0 += 2 * NGW) {
        int rr[2]; bool ok[2]; f32x4 t[2][4], xv[2][4];
#pragma unroll
        for (int u = 0; u < 2; ++u) { const int r = r0 + u * NGW; ok[u] = r < NTOK; rr[u] = ok[u] ? r : r0;
#pragma unroll
            for (int j = 0; j < 4; ++j) { const int col = 4 * (lane + 64 * j); t[u][j] = load_bf16x4(T2 + (size_t)rr[u] * D + col); xv[u][j] = load_bf16x4(X1 + (size_t)rr[u] * D + col); } }
#pragma unroll
        for (int u = 0; u < 2; ++u) { const float* m = mod + (size_t)(rr[u] >> 13) * (6 * D);
            float s = 0.f;
#pragma unroll
            for (int j = 0; j < 4; ++j) s += sumsq4(t[u][j]);
            const float rstd = rsqrtf(wave_sum(s) * (1.f / D) + EPS);
            if (ok[u]) {
#pragma unroll
                for (int j = 0; j < 4; ++j) { const int col = 4 * (lane + 64 * j);
                    const f32x4 g4 = *(const f32x4*)(gpost + col), gt = *(const f32x4*)(m + 5 * D + col);
                    *(f32x4*)(A.out + (size_t)rr[u] * D + col) = xv[u][j] + gt * (t[u][j] * rstd * g4); } } }
    }
}

constexpr int QS = 136, VS = 136, SSS = 136, AS = 72, KS = 72, ALS_STR = 40;
static_assert(VS == 136 && SSS == 136, "frag_tr4_136 hard-codes the row stride");
constexpr int L_QQ = 0;
constexpr int L_KK = L_QQ + 64 * QS * 2;
constexpr int L_VL = L_KK + 64 * QS * 2;
constexpr int L_SS = L_VL + 64 * VS * 2;
constexpr int L_AT = L_SS + 128 * SSS * 2;
constexpr int L_AL = L_AT + 64 * AS * 2;
constexpr int L_TOT = L_AL + 64 * 32 * 4;
constexpr int L_RS = L_TOT + 2 * 8 * 64 * 4;
constexpr int L_KR = L_RS + 512;
constexpr int L_QR = L_KR + 64 * KS * 2;
constexpr int L_KF = L_QQ, L_KB = L_KK;
static_assert(L_QR + 64 * KS * 2 <= LDS_STAGE, "GLA LDS");

struct GPre { v2u al; v4u q, k, v[2], s[4]; };
__device__ __forceinline__ void g_load_common(GPre& R, const bf16* P, size_t row0, int h, int tid) {
    const int s_tok = tid >> 3, s_c = tid & 7; const bf16* pr = P + (row0 + s_tok) * DINP;
    R.al = *(const v2u*)(pr + PC_AL + s_c * 4);
    R.k = *(const v4u*)(pr + PC_HEAD + h * PC_HSTRIDE + PC_K + s_c * 8);
#pragma unroll
    for (int i = 0; i < 2; ++i) { const int id = tid + NTHR * i, tok = id >> 4, ch = id & 15; R.v[i] = *(const v4u*)(P + (row0 + tok) * DINP + PC_HEAD + h * PC_HSTRIDE + PC_V + ch * 8); }
}
__device__ __forceinline__ void g_stage_common(const GPre& R, LAS unsigned char* lds, int tid) {
    LAS float* ALs = (LAS float*)(lds + L_AL); LAS bf16* KR = (LAS bf16*)(lds + L_KR); LAS bf16* VL = (LAS bf16*)(lds + L_VL);
    const int s_tok = tid >> 3, s_c = tid & 7;
    *(LAS v2u*)((LAS bf16*)ALs + s_tok * ALS_STR + s_c * 4) = R.al;
    *(LAS v4u*)(KR + s_tok * KS + s_c * 8) = R.k;
#pragma unroll
    for (int i = 0; i < 2; ++i) { const int id = tid + NTHR * i, tok = id >> 4, ch = id & 15; *(LAS v4u*)(VL + tok * VS + ch * 8) = R.v[i]; }
}
__device__ __forceinline__ void g_load_wfrag(const Args& A, int h, int dir, int nt, int lane, bf16x8& wfrag, float& bias) {
    const int g = lane >> 4, col = h * 64 + 16 * nt + (lane & 15);
    const float* w = dir ? A.in[13] : A.in[11];
    const bool live = dir ? (g >= 2) : (g < 2);
#pragma unroll
    for (int j = 0; j < 8; ++j) { const int r = (8 * g + j) & 15; const float v = live ? w[r * 256 + col] : 0.f; wfrag[j] = (short)f2bf(v); }
    bias = (dir ? A.in[14] : A.in[12])[col];
}
__device__ __forceinline__ void gla_gates(LAS unsigned char* lds, int lane, int dir, const bf16x8 wfrag, float bias, float (&Bc)[4][4], float& all) {
    const LAS bf16* ALb = (const LAS bf16*)(lds + L_AL);
    const int g = lane >> 4, li = lane & 15;
    float tot[4];
#pragma unroll
    for (int mt = 0; mt < 4; ++mt) {
        f32x4 acc = {bias, bias, bias, bias};
        acc = MFMA16(frag_row(ALb, ALS_STR, 16 * mt, 0, lane), wfrag, acc);
#pragma unroll
        for (int j = 0; j < 4; ++j) Bc[mt][j] = logsig2(acc[j]) * (1.f / 16.f);
        if (dir == 0) {
#pragma unroll
            for (int j = 1; j < 4; ++j) Bc[mt][j] += Bc[mt][j - 1];
            const float T = Bc[mt][3]; float sc = T;
            const float t1 = __shfl_up(sc, 16); sc += (g >= 1) ? t1 : 0.f;
            const float t2 = __shfl_up(sc, 32); sc += (g >= 2) ? t2 : 0.f;
            tot[mt] = __shfl(sc, 48 + li);
            const float ex = sc - T;
#pragma unroll
            for (int j = 0; j < 4; ++j) Bc[mt][j] += ex;
        } else {
#pragma unroll
            for (int j = 2; j >= 0; --j) Bc[mt][j] += Bc[mt][j + 1];
            const float T = Bc[mt][0]; float sc = T;
            const float t1 = __shfl_down(sc, 16); sc += (g <= 2) ? t1 : 0.f;
            const float t2 = __shfl_down(sc, 32); sc += (g <= 1) ? t2 : 0.f;
            tot[mt] = __shfl(sc, li);
            const float ex = sc - T;
#pragma unroll
            for (int j = 0; j < 4; ++j) Bc[mt][j] += ex;
        }
    }
    all = (tot[0] + tot[1]) + (tot[2] + tot[3]);
    if (dir == 0) { float off = 0.f;
#pragma unroll
        for (int mt = 0; mt < 4; ++mt) {
#pragma unroll
            for (int j = 0; j < 4; ++j) Bc[mt][j] += off;
            off += tot[mt]; }
    } else { float off = 0.f;
#pragma unroll
        for (int mt = 3; mt >= 0; --mt) {
#pragma unroll
            for (int j = 0; j < 4; ++j) Bc[mt][j] += off;
            off += tot[mt]; }
    }
}

__device__ __forceinline__ void g1_decode(int item, int& h, int& b, size_t& row0, int& nf, int& nb) {
    h = item & 3; const int cidx = (item >> 2) % NCH; b = item / (4 * NCH);
    row0 = cidx < 4 ? (size_t)NTOK + b * CTXL + cidx * 64 : (size_t)b * T + (cidx - 4) * 64;
    nf = cidx; nb = cidx < 4 ? 3 - cidx : 135 - cidx;
}
__device__ __forceinline__ void phase_g1(const Args& A, LAS unsigned char* lds, int tid, int lane, int wave) {
    const bf16* P = (const bf16*)(A.ws + WS_B); bf16* ST = (bf16*)(A.ws + WS_ST); float* DEC = (float*)(A.ws + WS_DEC);
    LAS bf16* KF = (LAS bf16*)(lds + L_KF); LAS bf16* KBk = (LAS bf16*)(lds + L_KB); LAS bf16* VL = (LAS bf16*)(lds + L_VL); LAS bf16* KR = (LAS bf16*)(lds + L_KR);
    const int NIT = NB * NCH * 4, gdir = wave >> 2, gnt = wave & 3;
    int hw = -1; bf16x8 wfrag = {0, 0, 0, 0, 0, 0, 0, 0}; float gbias = 0.f;
    GPre R;
    { int h, b, nf, nb; size_t row0; if ((int)blockIdx.x < NIT) { g1_decode(blockIdx.x, h, b, row0, nf, nb); g_load_common(R, P, row0, h, tid); } }
    for (int item = blockIdx.x; item < NIT; item += gridDim.x) {
        int h, b, nf, nb; size_t row0; g1_decode(item, h, b, row0, nf, nb);
        if (h != hw) { hw = h; g_load_wfrag(A, h, gdir, gnt, lane, wfrag, gbias); }
        g_stage_common(R, lds, tid);
        if (item + (int)gridDim.x < NIT) { int h2, b2, nf2, nb2; size_t row2; g1_decode(item + gridDim.x, h2, b2, row2, nf2, nb2); g_load_common(R, P, row2, h2, tid); }
        __syncthreads();
        float Bc[4][4], all;
        gla_gates(lds, lane, gdir, wfrag, gbias, Bc, all);
        { const int g4 = lane >> 4, dkc = 16 * gnt + (lane & 15); LAS bf16* Kd = gdir ? KBk : KF;
#pragma unroll
          for (int mt = 0; mt < 4; ++mt)
#pragma unroll
              for (int j = 0; j < 4; ++j) { const int tok = 16 * mt + 4 * g4 + j; const float kv = bf2f(KR[tok * KS + dkc]); Kd[tok * KS + dkc] = f2bf(kv * fexp2(all - Bc[mt][j])); }
          if (g4 == 0) DEC[((size_t)((b * 2 + gdir) * 4 + h) * NCH + (gdir ? nb : nf)) * 64 + dkc] = fexp2(all); }
        __syncthreads();
        { const int dir = wave >> 2, mt = wave & 3, g = lane >> 4;
          const LAS bf16* Kh = dir ? KBk : KF;
          const bf16x8 a0 = frag_tr(Kh, KS, 0, 16 * mt, lane), a1 = frag_tr(Kh, KS, 32, 16 * mt, lane);
          bf16* dst = ST + ((size_t)((b * 2 + dir) * 4 + h) * NCH + (dir ? nb : nf)) * 8192;
#pragma unroll
          for (int hf = 0; hf < 2; ++hf) { bf16x8 b0[4], b1[4]; frag_tr4_136(VL, 0, 64 * hf, lane, b0); frag_tr4_136(VL, 32, 64 * hf, lane, b1);
#pragma unroll
              for (int t = 0; t < 4; ++t) { const int nt = 4 * hf + t; f32x4 acc = {0.f, 0.f, 0.f, 0.f};
                  acc = MFMA16(a0, b0[t], acc); acc = MFMA16(a1, b1[t], acc);
#pragma unroll
                  for (int j = 0; j < 4; ++j) dst[(16 * mt + 4 * g + j) * 128 + 16 * nt + (lane & 15)] = f2bf(acc[j]); } } }
        __syncthreads();
    }
}

__device__ __forceinline__ void phase_g2(const Args& A, int tid) {
    bf16* ST = (bf16*)(A.ws + WS_ST); const float* DEC = (const float*)(A.ws + WS_DEC);
    for (int gt = blockIdx.x * NTHR + tid; gt < 64 * 2048; gt += gridDim.x * NTHR) {
        const int seq = gt >> 11, e = (gt & 2047) * 4, dk = e >> 7;
        bf16* base = ST + (size_t)seq * NCH * 8192 + e; const float* dec = DEC + (size_t)seq * NCH * 64 + dk;
        f32x4 S = {0.f, 0.f, 0.f, 0.f};
#pragma unroll 1
        for (int n0 = 0; n0 < NCH; n0 += 33) {
            v2u raw[33]; float d[33];
#pragma unroll
            for (int u = 0; u < 33; ++u) { raw[u] = *(const v2u*)(base + (size_t)(n0 + u) * 8192); d[u] = dec[(n0 + u) * 64]; }
#pragma unroll
            for (int u = 0; u < 33; ++u) {
                if (n0 + u >= 4) store_bf16x4(base + (size_t)(n0 + u) * 8192, S);
                f32x4 L; L[0] = bf2f(raw[u].x & 0xffffu); L[1] = bf2f(raw[u].x >> 16); L[2] = bf2f(raw[u].y & 0xffffu); L[3] = bf2f(raw[u].y >> 16);
                S = S * d[u] + L; }
        }
    }
}

__device__ __forceinline__ void phase_sconv(const Args& A, int tid) {
    const bf16* P = (const bf16*)(A.ws + WS_B); bf16* Y = (bf16*)(A.ws + WS_A); const float* w_sc = A.in[16]; const float* b_sc = A.in[17];
    const int gtid = blockIdx.x * NTHR + tid, ch = (gtid & 63) * 8;
    float w0[8], w1[8], w2[8], bs[8];
#pragma unroll
    for (int e = 0; e < 8; ++e) { w0[e] = w_sc[ch + e]; w1[e] = w_sc[512 + ch + e]; w2[e] = w_sc[1024 + ch + e]; bs[e] = b_sc[ch + e]; }
    const v4u zero = {0u, 0u, 0u, 0u};
    for (int it = gtid; it < (NTOK / 4) * 64; it += gridDim.x * NTHR) {
        const int tgp = it >> 6, c0 = (tgp & 15) * 4; const size_t tok0 = (size_t)tgp * 4;
        v4u C[6], X[6], SB[4];
#pragma unroll
        for (int i = 0; i < 6; ++i) { const int col = c0 + i - 1; const bool ok = col >= 0 && col < 64; const bf16* pr = P + (long)(tok0 + i - 1) * DINP;
            C[i] = ok ? *(const v4u*)(pr + COL_SC + ch) : zero; X[i] = ok ? *(const v4u*)(pr + COL_SX + ch) : zero; }
#pragma unroll
        for (int i = 0; i < 4; ++i) SB[i] = *(const v4u*)(P + (tok0 + i) * DINP + COL_SB + ch);
#pragma unroll
        for (int i = 0; i < 4; ++i) { v4u o;
#pragma unroll
            for (int e2 = 0; e2 < 4; ++e2) { float r2[2];
#pragma unroll
                for (int hh = 0; hh < 2; ++hh) { const int e = 2 * e2 + hh, sh = 16 * hh;
                    const float zm = bf2f((C[i][e2] >> sh) & 0xffffu) * bf2f((X[i][e2] >> sh) & 0xffffu), z0 = bf2f((C[i + 1][e2] >> sh) & 0xffffu) * bf2f((X[i + 1][e2] >> sh) & 0xffffu),
                                zp = bf2f((C[i + 2][e2] >> sh) & 0xffffu) * bf2f((X[i + 2][e2] >> sh) & 0xffffu);
                    r2[hh] = bf2f((SB[i][e2] >> sh) & 0xffffu) * (w0[e] * zm + w1[e] * z0 + w2[e] * zp + bs[e]); }
                o[e2] = pk2(r2[0], r2[1]); }
            *(v4u*)(Y + (tok0 + i) * D + 512 + ch) = o; }
    }
}

__device__ __forceinline__ void g3_load(GPre& R, const bf16* P, const bf16* ST, int item, int tid) {
    const int h = item & 3, lc = (item >> 2) & 127, b = item >> 9; const size_t row0 = (size_t)b * T + lc * 64; const int nf = 4 + lc, nb = 4 + 127 - lc;
    g_load_common(R, P, row0, h, tid);
    R.q = *(const v4u*)(P + (row0 + (tid >> 3)) * DINP + PC_HEAD + h * PC_HSTRIDE + PC_Q + (tid & 7) * 8);
#pragma unroll
    for (int i = 0; i < 4; ++i) { const int id = tid + NTHR * i, dirr = id >> 10, rem = id & 1023, r = rem >> 4, ch = rem & 15;
        R.s[i] = *(const v4u*)(ST + ((size_t)((b * 2 + dirr) * 4 + h) * NCH + (dirr ? nb : nf)) * 8192 + r * 128 + ch * 8); }
}
__device__ __forceinline__ void phase_g3(const Args& A, LAS unsigned char* lds, int tid0, int lane0, int wave) {
    const bf16* P = (const bf16*)(A.ws + WS_B); const bf16* ST = (const bf16*)(A.ws + WS_ST); bf16* Y = (bf16*)(A.ws + WS_A);
    LAS bf16* QQ = (LAS bf16*)(lds + L_QQ); LAS bf16* KK = (LAS bf16*)(lds + L_KK); LAS bf16* VL = (LAS bf16*)(lds + L_VL);
    LAS bf16* SS = (LAS bf16*)(lds + L_SS); LAS bf16* AT = (LAS bf16*)(lds + L_AT); LAS float* RS = (LAS float*)(lds + L_RS);
    LAS bf16* KR = (LAS bf16*)(lds + L_KR); LAS bf16* QR = (LAS bf16*)(lds + L_QR);
    const float* g_head = A.in[15];
    const int NIT = NB * 128 * 4;
    const int mt = wave & 3, ntb = (wave >> 2) * 4;
    const int gdir = wave >> 2, gnt = wave & 3;
    int hw = -1; bf16x8 wfrag = {0, 0, 0, 0, 0, 0, 0, 0}; float gbias = 0.f;
    float gh[4];
#pragma unroll
    for (int t = 0; t < 4; ++t) gh[t] = g_head[16 * (ntb + t) + (tid0 & 15)];
    GPre R;
    if ((int)blockIdx.x < NIT) g3_load(R, P, ST, blockIdx.x, tid0);
    for (int item = blockIdx.x; item < NIT; item += gridDim.x) {
        const int h = item & 3, lc = (item >> 2) & 127, b = item >> 9;
        const size_t row0 = (size_t)b * T + lc * 64;
        if (h != hw) { hw = h; g_load_wfrag(A, h, gdir, gnt, tid0 & 63, wfrag, gbias); }
        int tid = tid0; asm volatile("" : "+v"(tid));
        const int lane = tid & 63, g = lane >> 4, li = lane & 15;
        g_stage_common(R, lds, tid);
        *(LAS v4u*)(QR + (tid >> 3) * KS + (tid & 7) * 8) = R.q;
#pragma unroll
        for (int i = 0; i < 4; ++i) { const int id = tid + NTHR * i, dirr = id >> 10, rem = id & 1023, r = rem >> 4, ch = rem & 15; *(LAS v4u*)(SS + (dirr * 64 + r) * SSS + ch * 8) = R.s[i]; }
        if (item + (int)gridDim.x < NIT) g3_load(R, P, ST, item + gridDim.x, tid);
        __syncthreads();
        float Bc[4][4], all;
        gla_gates(lds, lane, gdir, wfrag, gbias, Bc, all);
        { const int dkc = 16 * gnt + li;
#pragma unroll
          for (int mt2 = 0; mt2 < 4; ++mt2)
#pragma unroll
              for (int j = 0; j < 4; ++j) { const int tok = 16 * mt2 + 4 * g + j;
                  const float qv = bf2f(QR[tok * KS + dkc]) * 0.125f, kv = bf2f(KR[tok * KS + dkc]);
                  QQ[tok * QS + gdir * 64 + dkc] = f2bf(qv * fexp2(Bc[mt2][j])); KK[tok * QS + gdir * 64 + dkc] = f2bf(kv * fexp2(-Bc[mt2][j])); } }
        unsigned ogr[4][4];
#pragma unroll
        for (int j = 0; j < 4; ++j)
#pragma unroll
            for (int t = 0; t < 4; ++t) ogr[j][t] = P[(row0 + 16 * mt + 4 * g + j) * DINP + PC_HEAD + h * PC_HSTRIDE + PC_OG + 16 * (ntb + t) + li];
        __syncthreads();
#pragma unroll
        for (int tt = 0; tt < 2; ++tt) { const int id = 2 * wave + tt, mt2 = id >> 2, nt = id & 3;
            f32x4 accF = {0.f, 0.f, 0.f, 0.f}, accB = {0.f, 0.f, 0.f, 0.f};
#pragma unroll
            for (int ks = 0; ks < 2; ++ks) { accF = MFMA16(frag_row(QQ, QS, 16 * mt2, 32 * ks, lane), frag_row(KK, QS, 16 * nt, 32 * ks, lane), accF);
                                             accB = MFMA16(frag_row(QQ, QS, 16 * mt2, 64 + 32 * ks, lane), frag_row(KK, QS, 16 * nt, 64 + 32 * ks, lane), accB); }
#pragma unroll
            for (int j = 0; j < 4; ++j) { const int ii = 16 * mt2 + 4 * g + j, jj = 16 * nt + li; AT[ii * AS + jj] = f2bf(jj <= ii ? accF[j] : accB[j]); } }
        __syncthreads();
        f32x4 acc[4];
#pragma unroll
        for (int t = 0; t < 4; ++t) acc[t] = (f32x4){0.f, 0.f, 0.f, 0.f};
#pragma unroll
        for (int ks = 0; ks < 2; ++ks) { const bf16x8 a = frag_row(AT, AS, 16 * mt, 32 * ks, lane); bf16x8 bb[4]; frag_tr4_136(VL, 32 * ks, 16 * ntb, lane, bb);
#pragma unroll
            for (int t = 0; t < 4; ++t) acc[t] = MFMA16(a, bb[t], acc[t]); }
#pragma unroll
        for (int ks = 0; ks < 4; ++ks) { const bf16x8 a = frag_row(QQ, QS, 16 * mt, 32 * ks, lane); bf16x8 bb[4]; frag_tr4_136(SS, 32 * ks, 16 * ntb, lane, bb);
#pragma unroll
            for (int t = 0; t < 4; ++t) acc[t] = MFMA16(a, bb[t], acc[t]); }
#pragma unroll
        for (int j = 0; j < 4; ++j) { float sq = 0.f;
#pragma unroll
            for (int t = 0; t < 4; ++t) sq += acc[t][j] * acc[t][j];
            sq += __shfl_xor(sq, 1); sq += __shfl_xor(sq, 2); sq += __shfl_xor(sq, 4); sq += __shfl_xor(sq, 8);
            if (li == 0) RS[(wave >> 2) * 64 + 16 * mt + 4 * g + j] = sq; }
        __syncthreads();
#pragma unroll
        for (int j = 0; j < 4; ++j) { const int row = 16 * mt + 4 * g + j; const float rstd = rsqrtf((RS[row] + RS[64 + row]) * (1.f / 128.f) + EPS);
#pragma unroll
            for (int t = 0; t < 4; ++t) { const int dv = 16 * (ntb + t) + li;
                Y[(row0 + row) * D + h * 128 + dv] = f2bf(acc[t][j] * rstd * gh[t] * silu(bf2f(ogr[j][t]))); } }
    }
}

__device__ __forceinline__ f32x2 bf2f2(unsigned w) { f32x2 r; r.x = __uint_as_float(w << 16); r.y = __uint_as_float(w & 0xffff0000u); return r; }
__device__ __forceinline__ void phase_conv(const Args& A, int tid) {
    const bf16* Uu = (const bf16*)(A.ws + WS_B); bf16* Ug = (bf16*)(A.ws + WS_UG); const float* w_cf = A.in[20]; const float* b_cf = A.in[21];
    constexpr int NU = (DFF / 256) * NB * 128;
    const int u0 = (int)((long)blockIdx.x * NU / gridDim.x), u1 = (int)((long)(blockIdx.x + 1) * NU / gridDim.x);
    const int c8l = tid & 31, cg = tid >> 5, c0 = 4 * cg;
    int cbw = -1; f32x2 w[9][4], bias[4];
#pragma unroll
    for (int k = 0; k < 9; ++k)
#pragma unroll
        for (int e = 0; e < 4; ++e) w[k][e] = (f32x2){0.f, 0.f};
#pragma unroll
    for (int e = 0; e < 4; ++e) bias[e] = (f32x2){0.f, 0.f};
    const v4u zero = {0u, 0u, 0u, 0u};
    for (int u = u0; u < u1; ++u) {
        const int cb = u >> 10, br = u & 1023, b = br >> 7, r = br & 127, ch = cb * 256 + c8l * 8;
        if (cb != cbw) { cbw = cb;
#pragma unroll
            for (int k = 0; k < 9; ++k) { const f32x4 wa = *(const f32x4*)(w_cf + k * DFF + ch), wb = *(const f32x4*)(w_cf + k * DFF + ch + 4);
                w[k][0] = (f32x2){wa[0], wa[1]}; w[k][1] = (f32x2){wa[2], wa[3]}; w[k][2] = (f32x2){wb[0], wb[1]}; w[k][3] = (f32x2){wb[2], wb[3]}; }
            const f32x4 ba = *(const f32x4*)(b_cf + ch), bb = *(const f32x4*)(b_cf + ch + 4);
            bias[0] = (f32x2){ba[0], ba[1]}; bias[1] = (f32x2){ba[2], ba[3]}; bias[2] = (f32x2){bb[0], bb[1]}; bias[3] = (f32x2){bb[2], bb[3]}; }
        const long tok0 = (long)b * T + r * 64;
        v4u X[3][6], gv[4];
#pragma unroll
        for (int dr = 0; dr < 3; ++dr) { const bool rv = (r + dr - 1 >= 0) && (r + dr - 1 < 128);
#pragma unroll
            for (int dc = 0; dc < 6; ++dc) { const int col = c0 + dc - 1; const bool ok = rv && col >= 0 && col < 64;
                X[dr][dc] = ok ? *(const v4u*)(Uu + (tok0 + (dr - 1) * 64 + col) * DFF + ch) : zero; } }
#pragma unroll
        for (int i = 0; i < 4; ++i) gv[i] = *(const v4u*)(Ug + (tok0 + c0 + i) * DFF + ch);
        f32x2 y[4][4];
#pragma unroll
        for (int i = 0; i < 4; ++i)
#pragma unroll
            for (int e2 = 0; e2 < 4; ++e2) y[i][e2] = bias[e2];
#pragma unroll
        for (int dr = 0; dr < 3; ++dr)
#pragma unroll
            for (int dc = 0; dc < 6; ++dc)
#pragma unroll
                for (int e2 = 0; e2 < 4; ++e2) { const f32x2 xv = bf2f2(X[dr][dc][e2]);
#pragma unroll
                    for (int t = 0; t < 3; ++t) { const int i = dc - t; if (i >= 0 && i < 4) y[i][e2] = y[i][e2] + w[dr * 3 + t][e2] * xv; } }
#pragma unroll
        for (int i = 0; i < 4; ++i) { v4u o;
#pragma unroll
            for (int e2 = 0; e2 < 4; ++e2) { const f32x2 gte = bf2f2(gv[i][e2]); const f32x2 yy = y[i][e2];
                f32x2 ex; ex.x = __builtin_amdgcn_exp2f(yy.x * -1.44269504f); ex.y = __builtin_amdgcn_exp2f(yy.y * -1.44269504f);
                const f32x2 den = ex + 1.0f; f32x2 rc; rc.x = __builtin_amdgcn_rcpf(den.x); rc.y = __builtin_amdgcn_rcpf(den.y);
                const f32x2 res = yy * rc * gte;
                o[e2] = pk2(res.x, res.y); }
            *(v4u*)(Ug + (tok0 + c0 + i) * DFF + ch) = o; }
    }
}

#define XB_TMO      128
#define XB_XCNT(j)  (256  + 64 * (j))
#define XB_XSUB(j)  (1280 + 64 * (j))
#define XB_XGEN(j)  (2304 + 64 * (j))
#define XB_TOP      3328
#define XB_TOPGEN   3392
#define XCD_BAR_WORDS 3456
#define XB_SPIN_CAP (1u << 18)

__device__ __forceinline__ unsigned xb_ld(unsigned* p)              { return __hip_atomic_load(p, __ATOMIC_RELAXED, __HIP_MEMORY_SCOPE_AGENT); }
__device__ __forceinline__ unsigned xb_add(unsigned* p, unsigned v) { return __hip_atomic_fetch_add(p, v, __ATOMIC_RELAXED, __HIP_MEMORY_SCOPE_AGENT); }
__device__ __forceinline__ unsigned xb_xcc_id() { return (unsigned)__builtin_amdgcn_s_getreg((3 << 11) | 20) & 0xFu; }
#define XB_SPIN(cond, bar) do { unsigned _sp = 0; while (cond) { __builtin_amdgcn_s_sleep(1); \
    if ((++_sp & 255u) == 0u) { if (xb_ld(&(bar)[XB_TMO])) break; if (_sp > XB_SPIN_CAP) { atomicAdd(&(bar)[XB_TMO], 1u); break; } } } } while (0)

struct XcdBarrier {
    unsigned* bar; unsigned x;
    volatile LAS unsigned* st;
};

__device__ __forceinline__ XcdBarrier xcd_barrier_post(unsigned* bar, volatile LAS unsigned* st) {
    XcdBarrier b; b.bar = bar; b.x = xb_xcc_id(); b.st = st;
    if (threadIdx.x == 0) (void)xb_add(&bar[XB_XCNT(b.x)], 1u);
    return b;
}
__device__ __forceinline__ void xcd_barrier_complete(unsigned* bar, unsigned x, unsigned& nloc, unsigned& nx) {
    const unsigned G = gridDim.x * gridDim.y * gridDim.z;
    unsigned sum, cnt, mine, sp = 0u;
    for (;;) {
        sum = 0u; cnt = 0u; mine = 0u;
#pragma unroll
        for (unsigned j = 0; j < 16; ++j) { const unsigned c = xb_ld(&bar[XB_XCNT(j)]); sum += c; cnt += (c > 0u) ? 1u : 0u; mine = (j == x) ? c : mine; }
        if (sum == G) break;
        __builtin_amdgcn_s_sleep(1);
        if ((++sp & 255u) == 0u) { if (xb_ld(&bar[XB_TMO])) break; if (sp > XB_SPIN_CAP) { atomicAdd(&bar[XB_TMO], 1u); break; } }
    }
    nloc = mine > 0u ? mine : 1u; nx = cnt > 0u ? cnt : 1u;
}

__device__ __forceinline__ void xcd_barrier(const XcdBarrier& b) {
    asm volatile("s_waitcnt vmcnt(0)" ::: "memory");
    __syncthreads();
    if (threadIdx.x == 0) {
        unsigned* bar = b.bar;
        __builtin_amdgcn_s_waitcnt(0);
        unsigned nloc = b.st[0], nx = b.st[1];
        if (nloc == 0u) { xcd_barrier_complete(bar, b.x, nloc, nx); b.st[0] = nloc; b.st[1] = nx; }
        const unsigned old = xb_add(&bar[XB_XSUB(b.x)], 1u);
        const unsigned gen = old / nloc;
        if (old + 1u == (gen + 1u) * nloc) {
            __builtin_amdgcn_fence(__ATOMIC_RELEASE, "agent");
            asm volatile("s_waitcnt vmcnt(0)" ::: "memory");
            const unsigned og = xb_add(&bar[XB_TOP], 1u);
            const unsigned tg = og / nx;
            if (og + 1u == (tg + 1u) * nx) xb_add(&bar[XB_TOPGEN], 1u);
            else XB_SPIN(xb_ld(&bar[XB_TOPGEN]) == tg, bar);
            __builtin_amdgcn_fence(__ATOMIC_ACQUIRE, "agent");
            xb_add(&bar[XB_XGEN(b.x)], 1u);
            asm volatile("s_waitcnt vmcnt(0)" ::: "memory");
        } else {
            XB_SPIN(xb_ld(&bar[XB_XGEN(b.x)]) == gen, bar);
            __builtin_amdgcn_fence(__ATOMIC_ACQUIRE, "agent");
            asm volatile("s_waitcnt vmcnt(0)" ::: "memory");
        }
    }
    __syncthreads();
}


__global__ void __launch_bounds__(NTHR, 2) fwd_mega(Args A) {
    extern __shared__ __attribute__((aligned(16))) unsigned char lds_raw[];
    LAS unsigned char* lds = (LAS unsigned char*)lds_raw;
    cg::grid_group grid = cg::this_grid();
#define PH_IDS() int tid = threadIdx.x; asm volatile("" : "+v"(tid)); const int lane = tid & 63, wave = __builtin_amdgcn_readfirstlane(tid >> 6); (void)lane; (void)wave
    unsigned char* ws = A.ws;
    const int G = gridDim.x, c = blockIdx.x;

    volatile LAS unsigned* bst = (volatile LAS unsigned*)(lds + LDS_STAGE);
    if (threadIdx.x < 16) bst[threadIdx.x] = 0u;
    unsigned* barw = (unsigned*)(ws + WS_BAR);
    __syncthreads();
    XcdBarrier bar = xcd_barrier_post(barw, bst);
    if (A.out == nullptr) grid.sync();
    { PH_IDS(); phase_mod(A, lds, tid); }
    xcd_barrier(bar);
#define SEAM() xcd_barrier(bar)
    if (__builtin_amdgcn_readfirstlane(threadIdx.x >> 6) & 1) { { PH_IDS(); phase_wprep(A, lds, tid, lane, wave); } { PH_IDS(); phase_rows1(A, lane, wave); } }
    else                                                      { { PH_IDS(); phase_rows1(A, lane, wave); } { PH_IDS(); phase_wprep(A, lds, tid, lane, wave); } }
    SEAM();
    {
        pg8::Gemm g{(const bf16*)(ws + WS_A), (const bf16*)(ws + WS_WIN), MROWS, DINP, D}; pg8::StaticOrder S; S.init(MROWS, DINP, G, c);
        pg8::EpiStore E{(bf16*)(ws + WS_B), DINP, 0, 0};
        pg8::gemm_phase<pg8::EpiStore, pg8::StaticOrder, false, true>(lds, g, S, E);
    }
    SEAM();
    { PH_IDS(); phase_g1(A, lds, tid, lane, wave); }
    SEAM();
    { PH_IDS(); phase_g2(A, tid); }
    { PH_IDS(); phase_sconv(A, tid); }
    SEAM();
    { PH_IDS(); phase_g3(A, lds, tid, lane, wave); }
    SEAM();
    {
        pg8::Gemm g{(const bf16*)(ws + WS_A), (const bf16*)(ws + WS_WOUT), NTOK, D, D}; pg8::StaticOrder S; S.init(NTOK, D, G, c);
        pg8::EpiStore E{(bf16*)(ws + WS_B), D, 0, 0};
        pg8::gemm_phase<pg8::EpiStore, pg8::StaticOrder, false, true>(lds, g, S, E);
    }
    SEAM();
    { PH_IDS(); phase_rows2(A, lane, wave); }
    SEAM();
    {
        pg8::Gemm g{(const bf16*)(ws + WS_A), (const bf16*)(ws + WS_WUP), NTOK, 2 * DFF, D}; pg8::StaticOrder S; S.init(NTOK, 2 * DFF, G, c);
        pg8::EpiStore E{(bf16*)(ws + WS_B), DFF, DFF, (size_t)NTOK * DFF};
        pg8::gemm_phase<pg8::EpiStore, pg8::StaticOrder, false, true>(lds, g, S, E);
    }
    SEAM();
    { PH_IDS(); phase_conv(A, tid); }
    SEAM();
    {
        pg8::Gemm g{(const bf16*)(ws + WS_UG), (const bf16*)(ws + WS_WDN), NTOK, D, DFF}; pg8::StaticOrder S; S.init(NTOK, D, G, c);
        pg8::EpiStore E{(bf16*)(ws + WS_A), D, 0, 0};
        pg8::gemm_phase<pg8::EpiStore, pg8::StaticOrder, false, true>(lds, g, S, E);
    }
    SEAM();
    { PH_IDS(); phase_rows3(A, lane, wave); }
}

extern "C" void kernel_launch(void* const* d_in, const int* in_sizes, int n_in, void* d_out, int out_size, void* d_ws, size_t ws_size, hipStream_t stream) {
    static int grid = 0;
    if (grid == 0) {
        if (n_in != 23 || ws_size < WS_END) { fprintf(stderr, "kernel_launch: unexpected n_in %d or ws_size %zu (< %zu)\n", n_in, ws_size, (size_t)WS_END); grid = -1; return; }
        int dev = 0, cus = 0, per_cu = 0;
        (void)hipGetDevice(&dev); (void)hipDeviceGetAttribute(&cus, hipDeviceAttributeMultiprocessorCount, dev);
        (void)hipFuncSetAttribute((const void*)fwd_mega, hipFuncAttributeMaxDynamicSharedMemorySize, LDS_BYTES);
        (void)hipOccupancyMaxActiveBlocksPerMultiprocessor(&per_cu, (const void*)fwd_mega, NTHR, LDS_BYTES);
        (void)per_cu;
        grid = cus;
        (void)hipGetLastError();
    }
    if (grid < 0) return;
    Args a{};
    for (int i = 0; i < 23; ++i) a.in[i] = (const float*)d_in[i];
    a.out = (float*)d_out; a.ws = (unsigned char*)d_ws;
    (void)hipMemsetAsync((unsigned char*)d_ws + WS_BAR, 0, XCD_BAR_WORDS * sizeof(unsigned), stream);
    void* args[] = {&a};
    hipError_t e = hipLaunchCooperativeKernel((const void*)fwd_mega, dim3(grid), dim3(NTHR), args, LDS_BYTES, stream);
    if (e != hipSuccess) fprintf(stderr, "cooperative launch failed: %s (grid %d)\n", hipGetErrorString(e), grid);
}
```

```cpp
#include <hip/hip_runtime.h>
#include <hip/hip_cooperative_groups.h>
#include <cstdio>
#include <cstdint>
namespace pg8 {
#define PG8_LAS __attribute__((address_space(3)))
typedef unsigned short bf16_t;
typedef short bf16x8 __attribute__((ext_vector_type(8)));
typedef float f32x4 __attribute__((ext_vector_type(4)));
typedef unsigned u32x4 __attribute__((ext_vector_type(4)));
constexpr int BM = 256, BK = 64, HALF = 128, HTB = HALF * BK * 2  , STAGE_BYTES = 8 * HTB, NXCD = 8, WGM = 4;

__host__ __device__ __forceinline__ int lds_byte(int r, int c) { const int st = (r >> 4) * 2 + (c >> 5), rr = r & 15, cc = c & 31, ob = rr * 64 + cc * 2; return st * 1024 + (ob ^ (((ob >> 9) & 1) << 5)); }
__host__ __device__ __forceinline__ void stage_rc(int b, int& R, int& C) { const int st = b / 1024, sb = b % 1024, swz = sb ^ (((sb >> 9) & 1) << 5); R = (st >> 1) * 16 + swz / 64; C = (st & 1) * 32 + (swz % 64) / 2; }
__host__ __device__ __forceinline__ int perm32(int rho) { const int n = rho >> 4, i = rho & 15; return 8 * (i >> 2) + 4 * n + (i & 3); }

struct Unit { int pm, pn; };
struct Gemm { const bf16_t* A; const bf16_t* Bt; int M, N, K; };

struct StaticOrder {
    int nM, nN, nwg, G, c;
    __host__ __device__ void init(int M, int N, int G_, int c_) { nM = M / BM; nN = N / BM; nwg = nM * nN; G = G_; c = c_; }
    __host__ __device__ bool next(int i, Unit& u) const {
        const long L = (long)i * G + c; if (L >= nwg) return false;
        int wgid = (int)L; { const int q = nwg / NXCD, r = nwg % NXCD, xcd = wgid % NXCD, off = wgid / NXCD; wgid = (xcd < r ? xcd * (q + 1) : r * (q + 1) + (xcd - r) * q) + off; }
        const int nig = WGM * nN, gid = wgid / nig, fm = gid * WGM, gsz = (nM - fm) < WGM ? (nM - fm) : WGM;
        u.pm = fm + ((wgid % nig) % gsz); u.pn = (wgid % nig) / gsz; return true;
    }
    __device__ __forceinline__ void a_ready(const Unit&) const {}
    __device__ __forceinline__ void done(const Unit&) const {}
};

typedef float f32x2c_t __attribute__((ext_vector_type(2))); typedef __bf16 bf16x2c_t __attribute__((ext_vector_type(2)));
__device__ __forceinline__ unsigned cvt_pk_bf16(float lo, float hi) { f32x2c_t v = {lo, hi}; bf16x2c_t b = __builtin_convertvector(v, bf16x2c_t); return __builtin_bit_cast(unsigned, b); }
struct EpiStore {
    static constexpr bool PERM = true, AFTER_DRAIN = false;
    bf16_t* O; int ldc; int split_cols; size_t split_stride;
    __device__ __forceinline__ void operator()(const f32x4 (&acc)[2][2][4][2], const Unit& u, int wr, int wc, int fr, int fq) const {
        const int row0 = u.pm * BM + wr * 64 + fr; int colt = u.pn * BM; bf16_t* base = O;
        if (split_cols) { const int t = colt / split_cols; base += (size_t)t * split_stride; colt -= t * split_cols; }
        const int col0 = colt + wc * 32 + 8 * fq;
#pragma unroll
        for (int ai = 0; ai < 2; ++ai)
#pragma unroll
            for (int m = 0; m < 4; ++m) { bf16_t* rowp = base + (size_t)(row0 + ai * HALF + m * 16) * ldc + col0;
#pragma unroll
                for (int bj = 0; bj < 2; ++bj) { const f32x4 v0 = acc[ai][bj][m][0], v1 = acc[ai][bj][m][1];
                    u32x4 w; w.x = cvt_pk_bf16(v0[0], v0[1]); w.y = cvt_pk_bf16(v0[2], v0[3]); w.z = cvt_pk_bf16(v1[0], v1[1]); w.w = cvt_pk_bf16(v1[2], v1[3]);
                    *(u32x4*)(rowp + bj * HALF) = w; } }
    }
};
template <class Epi, class Sched, bool ALIGN_EPI = false, bool SP2 = false>
__device__ __forceinline__ void gemm_phase(PG8_LAS unsigned char* lds, const Gemm g, const Sched& S, const Epi& E) {
    int tid_l = threadIdx.x; asm volatile("" : "+v"(tid_l));
    const int tid = tid_l, wid = __builtin_amdgcn_readfirstlane(tid >> 6), lane = tid & 63, wr = wid >> 2, wc = wid & 3, fr = lane & 15, fq = lane >> 4;
    const int K = g.K, nt = K / BK;
    unsigned voffA[2], voffB[2];
#pragma unroll
    for (int i = 0; i < 2; ++i) { int R, C; stage_rc(tid * 16 + i * 8192, R, C); const int Rb = Epi::PERM ? ((R & ~31) + perm32(R & 31)) : R;
        voffA[i] = (unsigned)(R * K + C) * 2u; voffB[i] = (unsigned)(Rb * K + C) * 2u; }
    const size_t kstep = (size_t)(BK * 2);
    const size_t hstep = (size_t)HALF * K * 2;
    const size_t tstep = 2 * hstep;
    const unsigned ldsw = (unsigned)wid * 1024u;
    const int aoff = lds_byte(wr * 64 + fr, fq * 8), boff = lds_byte(wc * 32 + fr, fq * 8);
#define PG8_SA(b, h) (((b) * 2 + (h)) * HTB)
#define PG8_SB(b, h) ((4 + (b) * 2 + (h)) * HTB)
#define PG8_STAGE(bufoff, gbase, voff) do { _Pragma("unroll") for (int _i = 0; _i < 2; ++_i) \
        __builtin_amdgcn_global_load_lds((const unsigned*)((const char*)(gbase) + (voff)[_i]), (PG8_LAS unsigned*)(lds + (bufoff) + ldsw + _i * 8192), 16, 0, 0); } while (0)
#define PG8_LDA(dst, b, h) do { _Pragma("unroll") for (int m = 0; m < 4; ++m) _Pragma("unroll") for (int k = 0; k < 2; ++k) dst[m][k] = *(const PG8_LAS bf16x8*)(lds + PG8_SA(b, h) + aoff + m * 2048 + k * 1024); } while (0)
#define PG8_LDB(dst, b, h) do { _Pragma("unroll") for (int n = 0; n < 2; ++n) _Pragma("unroll") for (int k = 0; k < 2; ++k) dst[n][k] = *(const PG8_LAS bf16x8*)(lds + PG8_SB(b, h) + boff + n * 2048 + k * 1024); } while (0)
#define PG8_MMA(ai, bj, At, Bt) do { __builtin_amdgcn_s_setprio(1); _Pragma("unroll") for (int m = 0; m < 4; ++m) _Pragma("unroll") for (int n = 0; n < 2; ++n) _Pragma("unroll") for (int k = 0; k < 2; ++k) \
        acc[ai][bj][m][n] = __builtin_amdgcn_mfma_f32_16x16x32_bf16(Bt[n][k], At[m][k], acc[ai][bj][m][n], 0, 0, 0); __builtin_amdgcn_s_setprio(0); } while (0)
#define PG8_WAIT_V(n) asm volatile("s_waitcnt vmcnt(" #n ")" ::: "memory")
#define PG8_WAIT_L(n) asm volatile("s_waitcnt lgkmcnt(" #n ")" ::: "memory")
#define PG8_BAR __builtin_amdgcn_s_barrier()
#define PG8_SCHED __builtin_amdgcn_sched_barrier(0)
    Unit cur, nxt; int ui = 0;
    if (!S.next(0, cur)) return;
    f32x4 acc[2][2][4][2];
#pragma unroll
    for (int a = 0; a < 2; ++a)
#pragma unroll
        for (int b = 0; b < 2; ++b)
#pragma unroll
            for (int m = 0; m < 4; ++m)
#pragma unroll
                for (int n = 0; n < 2; ++n) acc[a][b][m][n] = (f32x4){0.f, 0.f, 0.f, 0.f};
    bf16x8 At[4][2], B0[2][2], B1[2][2];
    const char* cA = (const char*)g.A + (size_t)cur.pm * tstep; const char* cB = (const char*)g.Bt + (size_t)cur.pn * tstep;
    S.a_ready(cur);
    if constexpr (SP2) {
        PG8_STAGE(PG8_SB(0, 0), cB, voffB); PG8_STAGE(PG8_SB(0, 1), cB + hstep, voffB); PG8_STAGE(PG8_SA(0, 0), cA, voffA); PG8_STAGE(PG8_SA(0, 1), cA + hstep, voffA);
        if (wr == 1) PG8_BAR;
        PG8_WAIT_V(2); PG8_BAR;
        PG8_STAGE(PG8_SB(1, 0), cB + kstep, voffB); PG8_STAGE(PG8_SA(1, 0), cA + kstep, voffA); PG8_STAGE(PG8_SB(1, 1), cB + hstep + kstep, voffB);
        PG8_WAIT_V(6); PG8_BAR;
    } else {
        PG8_STAGE(PG8_SB(0, 0), cB, voffB); PG8_STAGE(PG8_SA(0, 0), cA, voffA); PG8_STAGE(PG8_SB(0, 1), cB + hstep, voffB); PG8_STAGE(PG8_SA(0, 1), cA + hstep, voffA);
        if (wr == 1) PG8_BAR;
        PG8_WAIT_V(4); PG8_BAR;
        PG8_STAGE(PG8_SB(1, 0), cB + kstep, voffB); PG8_STAGE(PG8_SA(1, 0), cA + kstep, voffA); PG8_STAGE(PG8_SB(1, 1), cB + hstep + kstep, voffB);
        PG8_WAIT_V(6); PG8_BAR;
    }
    for (;;) {
        const bool has_next = S.next(ui + 1, nxt);
        const char* nA = has_next ? (const char*)g.A + (size_t)nxt.pm * tstep : cA; const char* nB = has_next ? (const char*)g.Bt + (size_t)nxt.pn * tstep : cB;
        for (int t = 0; t < nt; t += 2) {
            const bool last = (t == nt - 2);
            const char* a1 = cA + (size_t)(t + 1) * kstep;
            const char* a2 = last ? nA : cA + (size_t)(t + 2) * kstep; const char* b2 = last ? nB : cB + (size_t)(t + 2) * kstep;
            const char* a3 = a2 + kstep; const char* b3 = b2 + kstep;
            if (last && has_next) S.a_ready(nxt);
            if constexpr (SP2) {
            PG8_LDB(B0, 0, 0); PG8_LDB(B1, 0, 1); PG8_SCHED; PG8_LDA(At, 0, 0); PG8_STAGE(PG8_SA(1, 1), a1 + hstep, voffA);
            PG8_WAIT_V(8); PG8_WAIT_L(0); PG8_BAR; PG8_MMA(0, 0, At, B0); PG8_MMA(0, 1, At, B1); PG8_BAR; PG8_SCHED;
            PG8_LDA(At, 0, 1); PG8_STAGE(PG8_SB(0, 0), b2, voffB); PG8_STAGE(PG8_SB(0, 1), b2 + hstep, voffB); PG8_STAGE(PG8_SA(0, 0), a2, voffA);
            PG8_WAIT_V(8); PG8_WAIT_L(0); PG8_BAR; PG8_MMA(1, 0, At, B0); PG8_MMA(1, 1, At, B1); PG8_BAR; PG8_SCHED;
            PG8_LDB(B0, 1, 0); PG8_LDB(B1, 1, 1); PG8_SCHED; PG8_LDA(At, 1, 0); PG8_STAGE(PG8_SA(0, 1), a2 + hstep, voffA);
            PG8_WAIT_V(8); PG8_WAIT_L(0); PG8_BAR; PG8_MMA(0, 0, At, B0); PG8_MMA(0, 1, At, B1); PG8_BAR; PG8_SCHED;
            PG8_LDA(At, 1, 1); PG8_STAGE(PG8_SB(1, 0), b3, voffB); PG8_STAGE(PG8_SB(1, 1), b3 + hstep, voffB); PG8_STAGE(PG8_SA(1, 0), a3, voffA);
            PG8_WAIT_V(8); PG8_WAIT_L(0); PG8_BAR; PG8_MMA(1, 0, At, B0); PG8_MMA(1, 1, At, B1); PG8_BAR; PG8_SCHED;
            } else {
            PG8_LDB(B0, 0, 0); PG8_SCHED; PG8_LDA(At, 0, 0); PG8_STAGE(PG8_SA(1, 1), a1 + hstep, voffA);
            PG8_WAIT_L(8); PG8_BAR; PG8_WAIT_L(0); PG8_MMA(0, 0, At, B0); PG8_BAR; PG8_SCHED;
            PG8_LDB(B1, 0, 1); PG8_STAGE(PG8_SB(0, 0), b2, voffB);
            PG8_BAR; PG8_WAIT_L(0); PG8_MMA(0, 1, At, B1); PG8_BAR;
            PG8_LDA(At, 0, 1); PG8_STAGE(PG8_SA(0, 0), a2, voffA);
            PG8_BAR; PG8_WAIT_L(0); PG8_MMA(1, 0, At, B0); PG8_BAR; PG8_SCHED;
            PG8_STAGE(PG8_SB(0, 1), b2 + hstep, voffB);
            PG8_WAIT_V(6); PG8_BAR; PG8_MMA(1, 1, At, B1); PG8_BAR;
            PG8_LDB(B0, 1, 0); PG8_SCHED; PG8_LDA(At, 1, 0); PG8_STAGE(PG8_SA(0, 1), a2 + hstep, voffA);
            PG8_WAIT_L(8); PG8_BAR; PG8_WAIT_L(0); PG8_MMA(0, 0, At, B0); PG8_BAR; PG8_SCHED;
            PG8_LDB(B1, 1, 1); PG8_STAGE(PG8_SB(1, 0), b3, voffB);
            PG8_BAR; PG8_WAIT_L(0); PG8_MMA(0, 1, At, B1); PG8_BAR;
            PG8_LDA(At, 1, 1); PG8_STAGE(PG8_SA(1, 0), a3, voffA);
            PG8_BAR; PG8_WAIT_L(0); PG8_MMA(1, 0, At, B0); PG8_BAR; PG8_SCHED;
            PG8_STAGE(PG8_SB(1, 1), b3 + hstep, voffB);
            PG8_WAIT_V(6); PG8_BAR; PG8_MMA(1, 1, At, B1); PG8_BAR;
            }
        }
        if constexpr (ALIGN_EPI) { if (wr == 0) PG8_BAR; }
        if constexpr (!Epi::AFTER_DRAIN) { E(acc, cur, wr, wc, fr, fq); S.done(cur); }
        if (!has_next) break;
#pragma unroll
        for (int a = 0; a < 2; ++a)
#pragma unroll
            for (int b = 0; b < 2; ++b)
#pragma unroll
                for (int m = 0; m < 4; ++m)
#pragma unroll
                    for (int n = 0; n < 2; ++n) acc[a][b][m][n] = (f32x4){0.f, 0.f, 0.f, 0.f};
        cur = nxt; cA = nA; cB = nB; ++ui;
        if constexpr (ALIGN_EPI) { if (wr == 1) PG8_BAR; }
    }
    PG8_WAIT_V(0);
    if constexpr (!ALIGN_EPI) { if (wr == 0) PG8_BAR; }
    PG8_BAR;
    if constexpr (Epi::AFTER_DRAIN) { E.fused(acc, cur, wr, wc, fr, fq, lds, wid, lane); S.done(cur); }
#undef PG8_SA
#undef PG8_SB
#undef PG8_STAGE
#undef PG8_LDA
#undef PG8_LDB
#undef PG8_MMA
#undef PG8_WAIT_V
#undef PG8_WAIT_L
#undef PG8_BAR
#undef PG8_SCHED
}
}

namespace cg = cooperative_groups;
#define GRID_SYNC() do { asm volatile("s_waitcnt vmcnt(0)" ::: "memory"); grid.sync(); __builtin_amdgcn_fence(__ATOMIC_ACQUIRE, "agent"); asm volatile("s_waitcnt vmcnt(0)" ::: "memory"); } while (0)
#define LAS __attribute__((address_space(3)))
typedef unsigned short bf16;
typedef float f32x4 __attribute__((ext_vector_type(4)));
typedef short bf16x8 __attribute__((ext_vector_type(8)));
typedef short s16x4 __attribute__((ext_vector_type(4)));
typedef unsigned v4u __attribute__((ext_vector_type(4)));
typedef unsigned v2u __attribute__((ext_vector_type(2)));
typedef float f32x2 __attribute__((ext_vector_type(2)));

constexpr int D = 1024, NB = 8, T = 8192, NTOK = NB * T, CTXL = 256, NCTX = NB * CTXL, MROWS = NTOK + NCTX;
constexpr int DIN = 3104, DINP = 3328, DFF = 2816;
constexpr int COL_K = 0, COL_V = 256, COL_AF = 768, COL_AB = 784, COL_Q = 800, COL_OG = 1056, COL_SB = 1568, COL_SC = 2080, COL_SX = 2592;
constexpr int PC_AL = 0, PC_HEAD = 32, PC_HSTRIDE = 384, PC_K = 0, PC_V = 64, PC_Q = 192, PC_OG = 256;
__host__ __device__ constexpr int pcol32(int n0) {
    return n0 < COL_V ? PC_HEAD + (n0 / 64) * PC_HSTRIDE + PC_K + n0 % 64
         : n0 < COL_AF ? PC_HEAD + ((n0 - COL_V) / 128) * PC_HSTRIDE + PC_V + (n0 - COL_V) % 128
         : n0 < COL_Q ? PC_AL
         : n0 < COL_OG ? PC_HEAD + ((n0 - COL_Q) / 64) * PC_HSTRIDE + PC_Q + (n0 - COL_Q) % 64
         : n0 < COL_SB ? PC_HEAD + ((n0 - COL_OG) / 128) * PC_HSTRIDE + PC_OG + (n0 - COL_OG) % 128
         : n0;
}
constexpr int NCH = 132;
constexpr float EPS = 1e-6f;
constexpr int NTHR = 512, LDS_STAGE = 131072, LDS_BYTES = LDS_STAGE + 64;

constexpr size_t WS_MOD  = 0;
constexpr size_t WS_BAR  = 229376;
constexpr size_t WS_DEC  = 262144;
constexpr size_t WS_WIN  = WS_DEC + (size_t)NB * 2 * 4 * NCH * 64 * 4 + 0;
constexpr size_t WS_WOUT = WS_WIN + (size_t)DINP * D * 2;
constexpr size_t WS_WUP  = WS_WOUT + (size_t)D * D * 2;
constexpr size_t WS_WDN  = WS_WUP + (size_t)2 * DFF * D * 2;
constexpr size_t WS_A    = WS_WDN + (size_t)D * DFF * 2;
constexpr size_t WS_B    = WS_A + (size_t)MROWS * D * 2;
constexpr size_t WS_ST   = WS_B + (size_t)MROWS * DINP * 2;
constexpr size_t WS_UG   = WS_B + (size_t)NTOK * DFF * 2;
constexpr size_t WS_X1   = WS_B + (size_t)2 * NTOK * DFF * 2;
constexpr size_t WS_END  = WS_X1 + (size_t)NTOK * D * 2;
static_assert(WS_ST + (size_t)NB * 2 * 4 * NCH * 8192 * 2 <= WS_X1, "state buffer must fit under U");
static_assert(WS_WIN % 256 == 0 && WS_A % 256 == 0 && WS_B % 256 == 0 && WS_ST % 256 == 0, "alignment");

struct Args { const float* in[23]; float* out; unsigned char* ws; };

__device__ __forceinline__ float bf2f(unsigned v) { return __uint_as_float(v << 16); }
__device__ __forceinline__ unsigned pk2(float lo, float hi) { return pg8::cvt_pk_bf16(lo, hi); }
__device__ __forceinline__ bf16 f2bf(float v) { return (bf16)(pk2(v, 0.f) & 0xffffu); }
__device__ __forceinline__ float wave_sum(float v) {
#pragma unroll
    for (int o = 1; o < 64; o <<= 1) v += __shfl_xor(v, o);
    return v;
}
#define LDS_WAIT() asm volatile("s_waitcnt lgkmcnt(0)" ::: "memory")
__device__ __forceinline__ float fexp2(float x) { return __builtin_amdgcn_exp2f(x); }
__device__ __forceinline__ float logsig2(float a) { const float t = a * 1.44269504f; return fminf(t, 0.f) - __builtin_amdgcn_logf(1.f + fexp2(-fabsf(t))); }
__device__ __forceinline__ float silu(float a) { return a * __builtin_amdgcn_rcpf(1.f + fexp2(a * -1.44269504f)); }

__device__ __forceinline__ bf16x8 frag_row(const LAS bf16* base, int stride, int r0, int k0, int lane) {
    return *(const LAS bf16x8*)(base + (r0 + (lane & 15)) * stride + k0 + 8 * (lane >> 4));
}
__device__ __forceinline__ bf16x8 frag_tr(const LAS bf16* base, int stride, int k0, int x0, int lane) {
    const int g = lane >> 4, q = (lane & 15) >> 2, p = lane & 3;
    const unsigned a0 = (unsigned)(uintptr_t)(base + (k0 + 8 * g + q) * stride + x0 + 4 * p);
    const unsigned a1 = a0 + (unsigned)(4 * stride * 2);
    s16x4 lo, hi;
    asm volatile("ds_read_b64_tr_b16 %0, %2\n\tds_read_b64_tr_b16 %1, %3\n\ts_waitcnt lgkmcnt(0)" : "=&v"(lo), "=&v"(hi) : "v"(a0), "v"(a1) : "memory");
    bf16x8 r; r[0] = lo[0]; r[1] = lo[1]; r[2] = lo[2]; r[3] = lo[3]; r[4] = hi[0]; r[5] = hi[1]; r[6] = hi[2]; r[7] = hi[3];
    return r;
}
__device__ __forceinline__ void frag_tr4_136(const LAS bf16* base, int k0, int x0, int lane, bf16x8 (&out)[4]) {
    const int g = lane >> 4, q = (lane & 15) >> 2, p = lane & 3;
    const unsigned a = (unsigned)(uintptr_t)(base + (k0 + 8 * g + q) * 136 + x0 + 4 * p);
    s16x4 l0, l1, l2, l3, h0, h1, h2, h3;
    asm volatile("ds_read_b64_tr_b16 %0, %8\n\tds_read_b64_tr_b16 %1, %8 offset:32\n\tds_read_b64_tr_b16 %2, %8 offset:64\n\tds_read_b64_tr_b16 %3, %8 offset:96\n\t"
                 "ds_read_b64_tr_b16 %4, %8 offset:1088\n\tds_read_b64_tr_b16 %5, %8 offset:1120\n\tds_read_b64_tr_b16 %6, %8 offset:1152\n\tds_read_b64_tr_b16 %7, %8 offset:1184\n\ts_waitcnt lgkmcnt(0)"
                 : "=&v"(l0), "=&v"(l1), "=&v"(l2), "=&v"(l3), "=&v"(h0), "=&v"(h1), "=&v"(h2), "=&v"(h3) : "v"(a) : "memory");
#define PACK8(o, l, h) o[0] = l[0]; o[1] = l[1]; o[2] = l[2]; o[3] = l[3]; o[4] = h[0]; o[5] = h[1]; o[6] = h[2]; o[7] = h[3]
    PACK8(out[0], l0, h0); PACK8(out[1], l1, h1); PACK8(out[2], l2, h2); PACK8(out[3], l3, h3);
#undef PACK8
}
#define MFMA16(a, b, c) __builtin_amdgcn_mfma_f32_16x16x32_bf16((a), (b), (c), 0, 0, 0)

template <bool PERMUTE> __device__ __forceinline__ void transpose_item(const float* W, int K, int N, bf16* WT, LAS float* scr, int item, int lane) {
    const int nblk = N / 32, kb = item / nblk, nb = item % nblk, k0 = 64 * kb, n0 = 32 * nb, n0o = PERMUTE ? pcol32(n0) : n0;
#pragma unroll 8
    for (int i = 0; i < 32; ++i) { const int kk = 2 * i + (lane >> 5); scr[kk * 33 + (lane & 31)] = W[(size_t)(k0 + kk) * N + n0 + (lane & 31)]; }
    LDS_WAIT();
    const int c = lane & 7;
#pragma unroll
    for (int j = 0; j < 4; ++j) { const int n = (lane >> 3) + 8 * j; const LAS float* s = scr + (8 * c) * 33 + n;
        v4u o; o.x = pk2(s[0 * 33], s[1 * 33]); o.y = pk2(s[2 * 33], s[3 * 33]); o.z = pk2(s[4 * 33], s[5 * 33]); o.w = pk2(s[6 * 33], s[7 * 33]);
        *(v4u*)(WT + (size_t)(n0o + n) * K + k0 + 8 * c) = o; }
    LDS_WAIT();
}

__device__ __forceinline__ void phase_wprep(const Args& A, LAS unsigned char* lds, int tid, int lane, int wave) {
    unsigned char* ws = A.ws;
    bf16* WinT = (bf16*)(ws + WS_WIN); bf16* WoutT = (bf16*)(ws + WS_WOUT); bf16* WupT = (bf16*)(ws + WS_WUP); bf16* WdnT = (bf16*)(ws + WS_WDN);
    const int gw = blockIdx.x * 8 + wave, NGW = gridDim.x * 8;
    LAS float* scr = (LAS float*)(lds + wave * 8448);
    constexpr int I_IN = (D / 64) * (DIN / 32), I_OUT = (D / 64) * (D / 32), I_UP = (D / 64) * (2 * DFF / 32), I_DN = (DFF / 64) * (D / 32);
    for (int it = gw; it < I_IN + I_OUT + I_UP + I_DN; it += NGW) {
        int r = it;
        if (r < I_IN) { transpose_item<true>(A.in[10], D, DIN, WinT, scr, r, lane); continue; } r -= I_IN;
        if (r < I_OUT) { transpose_item<false>(A.in[18], D, D, WoutT, scr, r, lane); continue; } r -= I_OUT;
        if (r < I_UP) { transpose_item<false>(A.in[19], D, 2 * DFF, WupT, scr, r, lane); continue; } r -= I_UP;
        transpose_item<false>(A.in[22], DFF, D, WdnT, scr, r, lane);
    }
    { const size_t n16 = (size_t)(DINP - DIN) * D * 2 / 16; v4u* z = (v4u*)(WinT + (size_t)DIN * D);
      for (size_t i = (size_t)blockIdx.x * NTHR + tid; i < n16; i += (size_t)gridDim.x * NTHR) z[i] = (v4u){0u, 0u, 0u, 0u}; }
}
__device__ __forceinline__ void phase_mod(const Args& A, LAS unsigned char* lds, int tid) {
    unsigned char* ws = A.ws;
    float* mod = (float*)(ws + WS_MOD);
    LAS float* sil = (LAS float*)lds;
    LAS float* red = (LAS float*)(lds + 9 * 1024 * 4);
    const float* w_ada = A.in[4]; const float* b_ada = A.in[5];
    bool have = false;
    for (int item = blockIdx.x; item < 6 * D / 32; item += gridDim.x) {
        if (!have) {
            for (int i = tid; i < 9 * 1024; i += NTHR) { const float v = i < 8 * 1024 ? A.in[1][i] : A.in[3][i - 8 * 1024]; sil[i] = silu(v); }
            have = true;
        }
        __syncthreads();
        const int col = tid & 31, ks = tid >> 5, n = item * 32 + col;
        float acc[9];
#pragma unroll
        for (int r = 0; r < 9; ++r) acc[r] = 0.f;
#pragma unroll 16
        for (int i = 0; i < 64; ++i) { const int k = ks * 64 + i; const float w = w_ada[(size_t)k * (6 * D) + n];
#pragma unroll
            for (int r = 0; r < 9; ++r) acc[r] += sil[r * 1024 + k] * w; }
#pragma unroll
        for (int r = 0; r < 9; ++r) red[(ks * 9 + r) * 32 + col] = acc[r];
        __syncthreads();
        if (tid < 9 * 32) { const int r = tid >> 5, c2 = tid & 31; float s = b_ada[item * 32 + c2];
#pragma unroll
            for (int k2 = 0; k2 < 16; ++k2) s += red[(k2 * 9 + r) * 32 + c2];
            mod[r * (6 * D) + item * 32 + c2] = s; }
        __syncthreads();
    }
}

__device__ __forceinline__ void store_bf16x4(bf16* p, f32x4 v) { v2u o; o.x = pk2(v[0], v[1]); o.y = pk2(v[2], v[3]); *(v2u*)p = o; }
__device__ __forceinline__ f32x4 load_bf16x4(const bf16* p) { const v2u r = *(const v2u*)p; f32x4 v; v[0] = bf2f(r.x & 0xffffu); v[1] = bf2f(r.x >> 16); v[2] = bf2f(r.y & 0xffffu); v[3] = bf2f(r.y >> 16); return v; }
__device__ __forceinline__ float sumsq4(f32x4 v) { return (v[0] * v[0] + v[1] * v[1]) + (v[2] * v[2] + v[3] * v[3]); }

__device__ __forceinline__ void phase_rows1(const Args& A, int lane, int wave) {
    const float* mod = (const float*)(A.ws + WS_MOD); bf16* HX = (bf16*)(A.ws + WS_A); const float* g = A.in[6];
    const int gw = blockIdx.x * 8 + wave, NGW = gridDim.x * 8;
    for (int r0 = gw; r0 < MROWS; r0 += 2 * NGW) {
        int rr[2]; bool ok[2]; const float* src[2]; const float* m[2]; f32x4 v[2][4]; float s[2];
#pragma unroll
        for (int u = 0; u < 2; ++u) { const int r = r0 + u * NGW; ok[u] = r < MROWS; rr[u] = ok[u] ? r : r0;
            src[u] = rr[u] < NTOK ? A.in[0] + (size_t)rr[u] * D : A.in[2] + (size_t)(rr[u] - NTOK) * D; m[u] = mod + (size_t)(rr[u] < NTOK ? (rr[u] >> 13) : 8) * (6 * D); }
#pragma unroll
        for (int u = 0; u < 2; ++u) { s[u] = 0.f;
#pragma unroll
            for (int j = 0; j < 4; ++j) v[u][j] = ((const f32x4*)src[u])[lane + 64 * j]; }
#pragma unroll
        for (int u = 0; u < 2; ++u) {
#pragma unroll
            for (int j = 0; j < 4; ++j) s[u] += sumsq4(v[u][j]);
            const float rstd = rsqrtf(wave_sum(s[u]) * (1.f / D) + EPS);
            if (ok[u]) {
#pragma unroll
                for (int j = 0; j < 4; ++j) { const int col = 4 * (lane + 64 * j);
                    const f32x4 g4 = *(const f32x4*)(g + col), sh = *(const f32x4*)(m[u] + col), sc = *(const f32x4*)(m[u] + D + col);
                    const f32x4 y = v[u][j] * rstd * g4; store_bf16x4(HX + (size_t)rr[u] * D + col, y * (sc + 1.f) + sh); } } }
    }
}
__device__ __forceinline__ void phase_rows2(const Args& A, int lane, int wave) {
    const float* mod = (const float*)(A.ws + WS_MOD); const bf16* T1 = (const bf16*)(A.ws + WS_B); bf16* HX = (bf16*)(A.ws + WS_A); bf16* X1 = (bf16*)(A.ws + WS_X1);
    const float* gpost = A.in[7]; const float* gpre = A.in[8];
    const int gw = blockIdx.x * 8 + wave, NGW = gridDim.x * 8;
    for (int r0 = gw; r0 < NTOK; r0 += 2 * NGW) {
        int rr[2]; bool ok[2]; f32x4 t[2][4], xv[2][4];
#pragma unroll
        for (int u = 0; u < 2; ++u) { const int r = r0 + u * NGW; ok[u] = r < NTOK; rr[u] = ok[u] ? r : r0;
#pragma unroll
            for (int j = 0; j < 4; ++j) { const int col = 4 * (lane + 64 * j); t[u][j] = load_bf16x4(T1 + (size_t)rr[u] * D + col); xv[u][j] = *(const f32x4*)(A.in[0] + (size_t)rr[u] * D + col); } }
#pragma unroll
        for (int u = 0; u < 2; ++u) { const float* m = mod + (size_t)(rr[u] >> 13) * (6 * D);
            float s = 0.f;
#pragma unroll
            for (int j = 0; j < 4; ++j) s += sumsq4(t[u][j]);
            const float rstd = rsqrtf(wave_sum(s) * (1.f / D) + EPS);
            float s2 = 0.f;
#pragma unroll
            for (int j = 0; j < 4; ++j) { const int col = 4 * (lane + 64 * j);
                const f32x4 g4 = *(const f32x4*)(gpost + col), gt = *(const f32x4*)(m + 2 * D + col);
                xv[u][j] = xv[u][j] + gt * (t[u][j] * rstd * g4); s2 += sumsq4(xv[u][j]);
                if (ok[u]) store_bf16x4(X1 + (size_t)rr[u] * D + col, xv[u][j]); }
            const float rstd2 = rsqrtf(wave_sum(s2) * (1.f / D) + EPS);
            if (ok[u]) {
#pragma unroll
                for (int j = 0; j < 4; ++j) { const int col = 4 * (lane + 64 * j);
                    const f32x4 g4 = *(const f32x4*)(gpre + col), sh = *(const f32x4*)(m + 3 * D + col), sc = *(const f32x4*)(m + 4 * D + col);
                    const f32x4 y = xv[u][j] * rstd2 * g4; store_bf16x4(HX + (size_t)rr[u] * D + col, y * (sc + 1.f) + sh); } } }
    }
}
__device__ __forceinline__ void phase_rows3(const Args& A, int lane, int wave) {
    const float* mod = (const float*)(A.ws + WS_MOD); const bf16* T2 = (const bf16*)(A.ws + WS_A); const bf16* X1 = (const bf16*)(A.ws + WS_X1); const float* gpost = A.in[9];
    const int gw = blockIdx.x * 8 + wave, NGW = gridDim.x * 8;
    for (int r0 = gw; r0 < NTOK; r0 += 2 * NGW) {
        int rr[2]; bool ok[2]; f32x4 t[2][4], xv[2][4];
#pragma unroll
        for (int u = 0; u < 2; ++u) { const int r = r0 + u * NGW; ok[u] = r < NTOK; rr[u] = ok[u] ? r : r0;
#pragma unroll
            for (int j = 0; j < 4; ++j) { const int col = 4 * (lane + 64 * j); t[u][j] = load_bf16x4(T2 + (size_t)rr[u] * D + col); xv[u][j] = load_bf16x4(X1 + (size_t)rr[u] * D + col); } }
#pragma unroll
        for (int u = 0; u < 2; ++u) { const float* m = mod + (size_t)(rr[u] >> 13) * (6 * D);
            float s = 0.f;
#pragma unroll
            for (int j = 0; j < 4; ++j) s += sumsq4(t[u][j]);
            const float rstd = rsqrtf(wave_sum(s) * (1.f / D) + EPS);
            if (ok[u]) {
#pragma unroll
                for (int j = 0; j < 4; ++j) { const int col = 4 * (lane + 64 * j);
                    const f32x4 g4 = *(const f32x4*)(gpost + col), gt = *(const f32x4*)(m + 5 * D + col);
                    *(f32x4*)(A.out + (size_t)rr[u] * D + col) = xv[u][j] + gt * (t[u][j] * rstd * g4); } } }
    }
}

constexpr int QS = 136, VS = 136, SSS = 136, AS = 72, KS = 72, ALS_STR = 40;
static_assert(VS == 136 && SSS == 136, "frag_tr4_136 hard-codes the row stride");
constexpr int L_QQ = 0;
constexpr int L_KK = L_QQ + 64 * QS * 2;
constexpr int L_VL = L_KK + 64 * QS * 2;
constexpr int L_SS = L_VL + 64 * VS * 2;
constexpr int L_AT = L_SS + 128 * SSS * 2;
constexpr int L_AL = L_AT + 64 * AS * 2;
constexpr int L_TOT = L_AL + 64 * 32 * 4;
constexpr int L_RS = L_TOT + 2 * 8 * 64 * 4;
constexpr int L_KR = L_RS + 512;
constexpr int L_QR = L_KR + 64 * KS * 2;
constexpr int L_KF = L_QQ, L_KB = L_KK;
static_assert(L_QR + 64 * KS * 2 <= LDS_STAGE, "GLA LDS");

struct GPre { v2u al; v4u q, k, v[2], s[4]; };
__device__ __forceinline__ void g_load_common(GPre& R, const bf16* P, size_t row0, int h, int tid) {
    const int s_tok = tid >> 3, s_c = tid & 7; const bf16* pr = P + (row0 + s_tok) * DINP;
    R.al = *(const v2u*)(pr + PC_AL + s_c * 4);
    R.k = *(const v4u*)(pr + PC_HEAD + h * PC_HSTRIDE + PC_K + s_c * 8);
#pragma unroll
    for (int i = 0; i < 2; ++i) { const int id = tid + NTHR * i, tok = id >> 4, ch = id & 15; R.v[i] = *(const v4u*)(P + (row0 + tok) * DINP + PC_HEAD + h * PC_HSTRIDE + PC_V + ch * 8); }
}
__device__ __forceinline__ void g_stage_common(const GPre& R, LAS unsigned char* lds, int tid) {
    LAS float* ALs = (LAS float*)(lds + L_AL); LAS bf16* KR = (LAS bf16*)(lds + L_KR); LAS bf16* VL = (LAS bf16*)(lds + L_VL);
    const int s_tok = tid >> 3, s_c = tid & 7;
    *(LAS v2u*)((LAS bf16*)ALs + s_tok * ALS_STR + s_c * 4) = R.al;
    *(LAS v4u*)(KR + s_tok * KS + s_c * 8) = R.k;
#pragma unroll
    for (int i = 0; i < 2; ++i) { const int id = tid + NTHR * i, tok = id >> 4, ch = id & 15; *(LAS v4u*)(VL + tok * VS + ch * 8) = R.v[i]; }
}
__device__ __forceinline__ void g_load_wfrag(const Args& A, int h, int dir, int nt, int lane, bf16x8& wfrag, float& bias) {
    const int g = lane >> 4, col = h * 64 + 16 * nt + (lane & 15);
    const float* w = dir ? A.in[13] : A.in[11];
    const bool live = dir ? (g >= 2) : (g < 2);
#pragma unroll
    for (int j = 0; j < 8; ++j) { const int r = (8 * g + j) & 15; const float v = live ? w[r * 256 + col] : 0.f; wfrag[j] = (short)f2bf(v); }
    bias = (dir ? A.in[14] : A.in[12])[col];
}
__device__ __forceinline__ void gla_gates(LAS unsigned char* lds, int lane, int dir, const bf16x8 wfrag, float bias, float (&Bc)[4][4], float& all) {
    const LAS bf16* ALb = (const LAS bf16*)(lds + L_AL);
    const int g = lane >> 4, li = lane & 15;
    float tot[4];
#pragma unroll
    for (int mt = 0; mt < 4; ++mt) {
        f32x4 acc = {bias, bias, bias, bias};
        acc = MFMA16(frag_row(ALb, ALS_STR, 16 * mt, 0, lane), wfrag, acc);
#pragma unroll
        for (int j = 0; j < 4; ++j) Bc[mt][j] = logsig2(acc[j]) * (1.f / 16.f);
        if (dir == 0) {
#pragma unroll
            for (int j = 1; j < 4; ++j) Bc[mt][j] += Bc[mt][j - 1];
            const float T = Bc[mt][3]; float sc = T;
            const float t1 = __shfl_up(sc, 16); sc += (g >= 1) ? t1 : 0.f;
            const float t2 = __shfl_up(sc, 32); sc += (g >= 2) ? t2 : 0.f;
            tot[mt] = __shfl(sc, 48 + li);
            const float ex = sc - T;
#pragma unroll
            for (int j = 0; j < 4; ++j) Bc[mt][j] += ex;
        } else {
#pragma unroll
            for (int j = 2; j >= 0; --j) Bc[mt][j] += Bc[mt][j + 1];
            const float T = Bc[mt][0]; float sc = T;
            const float t1 = __shfl_down(sc, 16); sc += (g <= 2) ? t1 : 0.f;
            const float t2 = __shfl_down(sc, 32); sc += (g <= 1) ? t2 : 0.f;
            tot[mt] = __shfl(sc, li);
            const float ex = sc - T;
#pragma unroll
            for (int j = 0; j < 4; ++j) Bc[mt][j] += ex;
        }
    }
    all = (tot[0] + tot[1]) + (tot[2] + tot[3]);
    if (dir == 0) { float off = 0.f;
#pragma unroll
        for (int mt = 0; mt < 4; ++mt) {
#pragma unroll
            for (int j = 0; j < 4; ++j) Bc[mt][j] += off;
            off += tot[mt]; }
    } else { float off = 0.f;
#pragma unroll
        for (int mt = 3; mt >= 0; --mt) {
#pragma unroll
            for (int j = 0; j < 4; ++j) Bc[mt][j] += off;
            off += tot[mt]; }
    }
}

__device__ __forceinline__ void g1_decode(int item, int& h, int& b, size_t& row0, int& nf, int& nb) {
    h = item & 3; const int cidx = (item >> 2) % NCH; b = item / (4 * NCH);
    row0 = cidx < 4 ? (size_t)NTOK + b * CTXL + cidx * 64 : (size_t)b * T + (cidx - 4) * 64;
    nf = cidx; nb = cidx < 4 ? 3 - cidx : 135 - cidx;
}
__device__ __forceinline__ void phase_g1(const Args& A, LAS unsigned char* lds, int tid, int lane, int wave) {
    const bf16* P = (const bf16*)(A.ws + WS_B); bf16* ST = (bf16*)(A.ws + WS_ST); float* DEC = (float*)(A.ws + WS_DEC);
    LAS bf16* KF = (LAS bf16*)(lds + L_KF); LAS bf16* KBk = (LAS bf16*)(lds + L_KB); LAS bf16* VL = (LAS bf16*)(lds + L_VL); LAS bf16* KR = (LAS bf16*)(lds + L_KR);
    const int NIT = NB * NCH * 4, gdir = wave >> 2, gnt = wave & 3;
    int hw = -1; bf16x8 wfrag = {0, 0, 0, 0, 0, 0, 0, 0}; float gbias = 0.f;
    GPre R;
    { int h, b, nf, nb; size_t row0; if ((int)blockIdx.x < NIT) { g1_decode(blockIdx.x, h, b, row0, nf, nb); g_load_common(R, P, row0, h, tid); } }
    for (int item = blockIdx.x; item < NIT; item += gridDim.x) {
        int h, b, nf, nb; size_t row0; g1_decode(item, h, b, row0, nf, nb);
        if (h != hw) { hw = h; g_load_wfrag(A, h, gdir, gnt, lane, wfrag, gbias); }
        g_stage_common(R, lds, tid);
        if (item + (int)gridDim.x < NIT) { int h2, b2, nf2, nb2; size_t row2; g1_decode(item + gridDim.x, h2, b2, row2, nf2, nb2); g_load_common(R, P, row2, h2, tid); }
        __syncthreads();
        float Bc[4][4], all;
        gla_gates(lds, lane, gdir, wfrag, gbias, Bc, all);
        { const int g4 = lane >> 4, dkc = 16 * gnt + (lane & 15); LAS bf16* Kd = gdir ? KBk : KF;
#pragma unroll
          for (int mt = 0; mt < 4; ++mt)
#pragma unroll
              for (int j = 0; j < 4; ++j) { const int tok = 16 * mt + 4 * g4 + j; const float kv = bf2f(KR[tok * KS + dkc]); Kd[tok * KS + dkc] = f2bf(kv * fexp2(all - Bc[mt][j])); }
          if (g4 == 0) DEC[((size_t)((b * 2 + gdir) * 4 + h) * NCH + (gdir ? nb : nf)) * 64 + dkc] = fexp2(all); }
        __syncthreads();
        { const int dir = wave >> 2, mt = wave & 3, g = lane >> 4;
          const LAS bf16* Kh = dir ? KBk : KF;
          const bf16x8 a0 = frag_tr(Kh, KS, 0, 16 * mt, lane), a1 = frag_tr(Kh, KS, 32, 16 * mt, lane);
          bf16* dst = ST + ((size_t)((b * 2 + dir) * 4 + h) * NCH + (dir ? nb : nf)) * 8192;
#pragma unroll
          for (int hf = 0; hf < 2; ++hf) { bf16x8 b0[4], b1[4]; frag_tr4_136(VL, 0, 64 * hf, lane, b0); frag_tr4_136(VL, 32, 64 * hf, lane, b1);
#pragma unroll
              for (int t = 0; t < 4; ++t) { const int nt = 4 * hf + t; f32x4 acc = {0.f, 0.f, 0.f, 0.f};
                  acc = MFMA16(a0, b0[t], acc); acc = MFMA16(a1, b1[t], acc);
#pragma unroll
                  for (int j = 0; j < 4; ++j) dst[(16 * mt + 4 * g + j) * 128 + 16 * nt + (lane & 15)] = f2bf(acc[j]); } } }
        __syncthreads();
    }
}

__device__ __forceinline__ void phase_g2(const Args& A, int tid) {
    bf16* ST = (bf16*)(A.ws + WS_ST); const float* DEC = (const float*)(A.ws + WS_DEC);
    for (int gt = blockIdx.x * NTHR + tid; gt < 64 * 2048; gt += gridDim.x * NTHR) {
        const int seq = gt >> 11, e = (gt & 2047) * 4, dk = e >> 7;
        bf16* base = ST + (size_t)seq * NCH * 8192 + e; const float* dec = DEC + (size_t)seq * NCH * 64 + dk;
        f32x4 S = {0.f, 0.f, 0.f, 0.f};
#pragma unroll 1
        for (int n0 = 0; n0 < NCH; n0 += 33) {
            v2u raw[33]; float d[33];
#pragma unroll
            for (int u = 0; u < 33; ++u) { raw[u] = *(const v2u*)(base + (size_t)(n0 + u) * 8192); d[u] = dec[(n0 + u) * 64]; }
#pragma unroll
            for (int u = 0; u < 33; ++u) {
                if (n0 + u >= 4) store_bf16x4(base + (size_t)(n0 + u) * 8192, S);
                f32x4 L; L[0] = bf2f(raw[u].x & 0xffffu); L[1] = bf2f(raw[u].x >> 16); L[2] = bf2f(raw[u].y & 0xffffu); L[3] = bf2f(raw[u].y >> 16);
                S = S * d[u] + L; }
        }
    }
}

__device__ __forceinline__ void phase_sconv(const Args& A, int tid) {
    const bf16* P = (const bf16*)(A.ws + WS_B); bf16* Y = (bf16*)(A.ws + WS_A); const float* w_sc = A.in[16]; const float* b_sc = A.in[17];
    const int gtid = blockIdx.x * NTHR + tid, ch = (gtid & 63) * 8;
    float w0[8], w1[8], w2[8], bs[8];
#pragma unroll
    for (int e = 0; e < 8; ++e) { w0[e] = w_sc[ch + e]; w1[e] = w_sc[512 + ch + e]; w2[e] = w_sc[1024 + ch + e]; bs[e] = b_sc[ch + e]; }
    const v4u zero = {0u, 0u, 0u, 0u};
    for (int it = gtid; it < (NTOK / 4) * 64; it += gridDim.x * NTHR) {
        const int tgp = it >> 6, c0 = (tgp & 15) * 4; const size_t tok0 = (size_t)tgp * 4;
        v4u C[6], X[6], SB[4];
#pragma unroll
        for (int i = 0; i < 6; ++i) { const int col = c0 + i - 1; const bool ok = col >= 0 && col < 64; const bf16* pr = P + (long)(tok0 + i - 1) * DINP;
            C[i] = ok ? *(const v4u*)(pr + COL_SC + ch) : zero; X[i] = ok ? *(const v4u*)(pr + COL_SX + ch) : zero; }
#pragma unroll
        for (int i = 0; i < 4; ++i) SB[i] = *(const v4u*)(P + (tok0 + i) * DINP + COL_SB + ch);
#pragma unroll
        for (int i = 0; i < 4; ++i) { v4u o;
#pragma unroll
            for (int e2 = 0; e2 < 4; ++e2) { float r2[2];
#pragma unroll
                for (int hh = 0; hh < 2; ++hh) { const int e = 2 * e2 + hh, sh = 16 * hh;
                    const float zm = bf2f((C[i][e2] >> sh) & 0xffffu) * bf2f((X[i][e2] >> sh) & 0xffffu), z0 = bf2f((C[i + 1][e2] >> sh) & 0xffffu) * bf2f((X[i + 1][e2] >> sh) & 0xffffu),
                                zp = bf2f((C[i + 2][e2] >> sh) & 0xffffu) * bf2f((X[i + 2][e2] >> sh) & 0xffffu);
                    r2[hh] = bf2f((SB[i][e2] >> sh) & 0xffffu) * (w0[e] * zm + w1[e] * z0 + w2[e] * zp + bs[e]); }
                o[e2] = pk2(r2[0], r2[1]); }
            *(v4u*)(Y + (tok0 + i) * D + 512 + ch) = o; }
    }
}

__device__ __forceinline__ void g3_load(GPre& R, const bf16* P, const bf16* ST, int item, int tid) {
    const int h = item & 3, lc = (item >> 2) & 127, b = item >> 9; const size_t row0 = (size_t)b * T + lc * 64; const int nf = 4 + lc, nb = 4 + 127 - lc;
    g_load_common(R, P, row0, h, tid);
    R.q = *(const v4u*)(P + (row0 + (tid >> 3)) * DINP + PC_HEAD + h * PC_HSTRIDE + PC_Q + (tid & 7) * 8);
#pragma unroll
    for (int i = 0; i < 4; ++i) { const int id = tid + NTHR * i, dirr = id >> 10, rem = id & 1023, r = rem >> 4, ch = rem & 15;
        R.s[i] = *(const v4u*)(ST + ((size_t)((b * 2 + dirr) * 4 + h) * NCH + (dirr ? nb : nf)) * 8192 + r * 128 + ch * 8); }
}
__device__ __forceinline__ void phase_g3(const Args& A, LAS unsigned char* lds, int tid0, int lane0, int wave, bool sc_embed) {
    const bf16* P = (const bf16*)(A.ws + WS_B); const bf16* ST = (const bf16*)(A.ws + WS_ST); bf16* Y = (bf16*)(A.ws + WS_A);
    LAS bf16* QQ = (LAS bf16*)(lds + L_QQ); LAS bf16* KK = (LAS bf16*)(lds + L_KK); LAS bf16* VL = (LAS bf16*)(lds + L_VL);
    LAS bf16* SS = (LAS bf16*)(lds + L_SS); LAS bf16* AT = (LAS bf16*)(lds + L_AT); LAS float* RS = (LAS float*)(lds + L_RS);
    LAS bf16* KR = (LAS bf16*)(lds + L_KR); LAS bf16* QR = (LAS bf16*)(lds + L_QR);
    const float* g_head = A.in[15];
    const int NIT = NB * 128 * 4;
    const int mt = wave & 3, ntb = (wave >> 2) * 4;
    const int gdir = wave >> 2, gnt = wave & 3;
    int hw = -1; bf16x8 wfrag = {0, 0, 0, 0, 0, 0, 0, 0}; float gbias = 0.f;
    float gh[4];
#pragma unroll
    for (int t = 0; t < 4; ++t) gh[t] = g_head[16 * (ntb + t) + (tid0 & 15)];
    const float* w_sc = A.in[16]; const float* b_sc = A.in[17];
    const int sc_gt = blockIdx.x * NTHR + tid0, sc_ch = (sc_gt & 63) * 8;
    GPre R;
    if ((int)blockIdx.x < NIT) g3_load(R, P, ST, blockIdx.x, tid0);
    for (int item = blockIdx.x; item < NIT; item += gridDim.x) {
        const int h = item & 3, lc = (item >> 2) & 127, b = item >> 9;
        const size_t row0 = (size_t)b * T + lc * 64;
        if (h != hw) { hw = h; g_load_wfrag(A, h, gdir, gnt, tid0 & 63, wfrag, gbias); }
        int tid = tid0; asm volatile("" : "+v"(tid));
        const int lane = tid & 63, g = lane >> 4, li = lane & 15;
        g_stage_common(R, lds, tid);
        *(LAS v4u*)(QR + (tid >> 3) * KS + (tid & 7) * 8) = R.q;
#pragma unroll
        for (int i = 0; i < 4; ++i) { const int id = tid + NTHR * i, dirr = id >> 10, rem = id & 1023, r = rem >> 4, ch = rem & 15; *(LAS v4u*)(SS + (dirr * 64 + r) * SSS + ch * 8) = R.s[i]; }
        if (item + (int)gridDim.x < NIT) g3_load(R, P, ST, item + gridDim.x, tid);
        __syncthreads();
        float Bc[4][4], all;
        gla_gates(lds, lane, gdir, wfrag, gbias, Bc, all);
        { const int dkc = 16 * gnt + li;
#pragma unroll
          for (int mt2 = 0; mt2 < 4; ++mt2)
#pragma unroll
              for (int j = 0; j < 4; ++j) { const int tok = 16 * mt2 + 4 * g + j;
                  const float qv = bf2f(QR[tok * KS + dkc]) * 0.125f, kv = bf2f(KR[tok * KS + dkc]);
                  QQ[tok * QS + gdir * 64 + dkc] = f2bf(qv * fexp2(Bc[mt2][j])); KK[tok * QS + gdir * 64 + dkc] = f2bf(kv * fexp2(-Bc[mt2][j])); } }
        unsigned ogr[4][4];
#pragma unroll
        for (int j = 0; j < 4; ++j)
#pragma unroll
            for (int t = 0; t < 4; ++t) ogr[j][t] = P[(row0 + 16 * mt + 4 * g + j) * DINP + PC_HEAD + h * PC_HSTRIDE + PC_OG + 16 * (ntb + t) + li];
        const int sc_tp = (((item - (int)blockIdx.x) / (int)gridDim.x) * ((int)gridDim.x * NTHR) + sc_gt) >> 6; const size_t sc_tok0 = (size_t)sc_tp * 2; const int sc_c0 = (sc_tp * 2) & 63;
        v4u scC[4], scX[4], scB[2]; f32x4 scW[8];
        if (sc_embed) {
#pragma unroll
            for (int i = 0; i < 4; ++i) { const int col = sc_c0 + i - 1; const bool ok = col >= 0 && col < 64; const bf16* pr = P + (long)(sc_tok0 + i - 1) * DINP;
                scC[i] = ok ? *(const v4u*)(pr + COL_SC + sc_ch) : (v4u){0u, 0u, 0u, 0u}; scX[i] = ok ? *(const v4u*)(pr + COL_SX + sc_ch) : (v4u){0u, 0u, 0u, 0u}; }
#pragma unroll
            for (int i = 0; i < 2; ++i) scB[i] = *(const v4u*)(P + (sc_tok0 + i) * DINP + COL_SB + sc_ch);
#pragma unroll
            for (int k = 0; k < 3; ++k) { scW[2 * k] = *(const f32x4*)(w_sc + 512 * k + sc_ch); scW[2 * k + 1] = *(const f32x4*)(w_sc + 512 * k + sc_ch + 4); }
            scW[6] = *(const f32x4*)(b_sc + sc_ch); scW[7] = *(const f32x4*)(b_sc + sc_ch + 4);
        }
        __syncthreads();
#pragma unroll
        for (int tt = 0; tt < 2; ++tt) { const int id = 2 * wave + tt, mt2 = id >> 2, nt = id & 3;
            f32x4 accF = {0.f, 0.f, 0.f, 0.f}, accB = {0.f, 0.f, 0.f, 0.f};
#pragma unroll
            for (int ks = 0; ks < 2; ++ks) { accF = MFMA16(frag_row(QQ, QS, 16 * mt2, 32 * ks, lane), frag_row(KK, QS, 16 * nt, 32 * ks, lane), accF);
                                             accB = MFMA16(frag_row(QQ, QS, 16 * mt2, 64 + 32 * ks, lane), frag_row(KK, QS, 16 * nt, 64 + 32 * ks, lane), accB); }
#pragma unroll
            for (int j = 0; j < 4; ++j) { const int ii = 16 * mt2 + 4 * g + j, jj = 16 * nt + li; AT[ii * AS + jj] = f2bf(jj <= ii ? accF[j] : accB[j]); } }
        __syncthreads();
        f32x4 acc[4];
#pragma unroll
        for (int t = 0; t < 4; ++t) acc[t] = (f32x4){0.f, 0.f, 0.f, 0.f};
#pragma unroll
        for (int ks = 0; ks < 2; ++ks) { const bf16x8 a = frag_row(AT, AS, 16 * mt, 32 * ks, lane); bf16x8 bb[4]; frag_tr4_136(VL, 32 * ks, 16 * ntb, lane, bb);
#pragma unroll
            for (int t = 0; t < 4; ++t) acc[t] = MFMA16(a, bb[t], acc[t]); }
#pragma unroll
        for (int ks = 0; ks < 4; ++ks) { const bf16x8 a = frag_row(QQ, QS, 16 * mt, 32 * ks, lane); bf16x8 bb[4]; frag_tr4_136(SS, 32 * ks, 16 * ntb, lane, bb);
#pragma unroll
            for (int t = 0; t < 4; ++t) acc[t] = MFMA16(a, bb[t], acc[t]); }
#pragma unroll
        for (int j = 0; j < 4; ++j) { float sq = 0.f;
#pragma unroll
            for (int t = 0; t < 4; ++t) sq += acc[t][j] * acc[t][j];
            sq += __shfl_xor(sq, 1); sq += __shfl_xor(sq, 2); sq += __shfl_xor(sq, 4); sq += __shfl_xor(sq, 8);
            if (li == 0) RS[(wave >> 2) * 64 + 16 * mt + 4 * g + j] = sq; }
        __syncthreads();
#pragma unroll
        for (int j = 0; j < 4; ++j) { const int row = 16 * mt + 4 * g + j; const float rstd = rsqrtf((RS[row] + RS[64 + row]) * (1.f / 128.f) + EPS);
#pragma unroll
            for (int t = 0; t < 4; ++t) { const int dv = 16 * (ntb + t) + li;
                Y[(row0 + row) * D + h * 128 + dv] = f2bf(acc[t][j] * rstd * gh[t] * silu(bf2f(ogr[j][t]))); } }
        if (sc_embed) {
#pragma unroll
            for (int i = 0; i < 2; ++i) { v4u o;
#pragma unroll
                for (int e2 = 0; e2 < 4; ++e2) { float r2[2];
#pragma unroll
                    for (int hh = 0; hh < 2; ++hh) { const int e = 2 * e2 + hh, sh = 16 * hh;
                        const float zm = bf2f((scC[i][e2] >> sh) & 0xffffu) * bf2f((scX[i][e2] >> sh) & 0xffffu), z0 = bf2f((scC[i + 1][e2] >> sh) & 0xffffu) * bf2f((scX[i + 1][e2] >> sh) & 0xffffu),
                                    zp = bf2f((scC[i + 2][e2] >> sh) & 0xffffu) * bf2f((scX[i + 2][e2] >> sh) & 0xffffu);
                        r2[hh] = bf2f((scB[i][e2] >> sh) & 0xffffu) * (scW[e >> 2][e & 3] * zm + scW[2 + (e >> 2)][e & 3] * z0 + scW[4 + (e >> 2)][e & 3] * zp + scW[6 + (e >> 2)][e & 3]); }
                    o[e2] = pk2(r2[0], r2[1]); }
                *(v4u*)(Y + (sc_tok0 + i) * D + 512 + sc_ch) = o; } }
    }
}

__device__ __forceinline__ f32x2 bf2f2(unsigned w) { f32x2 r; r.x = __uint_as_float(w << 16); r.y = __uint_as_float(w & 0xffff0000u); return r; }
__device__ __forceinline__ void phase_conv(const Args& A, int tid) {
    const bf16* Uu = (const bf16*)(A.ws + WS_B); bf16* Ug = (bf16*)(A.ws + WS_UG); const float* w_cf = A.in[20]; const float* b_cf = A.in[21];
    constexpr int NU = (DFF / 256) * NB * 128;
    const int u0 = (int)((long)blockIdx.x * NU / gridDim.x), u1 = (int)((long)(blockIdx.x + 1) * NU / gridDim.x);
    const int c8l = tid & 31, cg = tid >> 5, c0 = 4 * cg;
    int cbw = -1; f32x2 w[9][4], bias[4];
#pragma unroll
    for (int k = 0; k < 9; ++k)
#pragma unroll
        for (int e = 0; e < 4; ++e) w[k][e] = (f32x2){0.f, 0.f};
#pragma unroll
    for (int e = 0; e < 4; ++e) bias[e] = (f32x2){0.f, 0.f};
    const v4u zero = {0u, 0u, 0u, 0u};
    for (int u = u0; u < u1; ++u) {
        const int cb = u >> 10, br = u & 1023, b = br >> 7, r = br & 127, ch = cb * 256 + c8l * 8;
        if (cb != cbw) { cbw = cb;
#pragma unroll
            for (int k = 0; k < 9; ++k) { const f32x4 wa = *(const f32x4*)(w_cf + k * DFF + ch), wb = *(const f32x4*)(w_cf + k * DFF + ch + 4);
                w[k][0] = (f32x2){wa[0], wa[1]}; w[k][1] = (f32x2){wa[2], wa[3]}; w[k][2] = (f32x2){wb[0], wb[1]}; w[k][3] = (f32x2){wb[2], wb[3]}; }
            const f32x4 ba = *(const f32x4*)(b_cf + ch), bb = *(const f32x4*)(b_cf + ch + 4);
            bias[0] = (f32x2){ba[0], ba[1]}; bias[1] = (f32x2){ba[2], ba[3]}; bias[2] = (f32x2){bb[0], bb[1]}; bias[3] = (f32x2){bb[2], bb[3]}; }
        const long tok0 = (long)b * T + r * 64;
        v4u X[3][6], gv[4];
#pragma unroll
        for (int dr = 0; dr < 3; ++dr) { const bool rv = (r + dr - 1 >= 0) && (r + dr - 1 < 128);
#pragma unroll
            for (int dc = 0; dc < 6; ++dc) { const int col = c0 + dc - 1; const bool ok = rv && col >= 0 && col < 64;
                X[dr][dc] = ok ? *(const v4u*)(Uu + (tok0 + (dr - 1) * 64 + col) * DFF + ch) : zero; } }
#pragma unroll
        for (int i = 0; i < 4; ++i) gv[i] = *(const v4u*)(Ug + (tok0 + c0 + i) * DFF + ch);
        f32x2 y[4][4];
#pragma unroll
        for (int i = 0; i < 4; ++i)
#pragma unroll
            for (int e2 = 0; e2 < 4; ++e2) y[i][e2] = bias[e2];
#pragma unroll
        for (int dr = 0; dr < 3; ++dr)
#pragma unroll
            for (int dc = 0; dc < 6; ++dc)
#pragma unroll
                for (int e2 = 0; e2 < 4; ++e2) { const f32x2 xv = bf2f2(X[dr][dc][e2]);
#pragma unroll
                    for (int t = 0; t < 3; ++t) { const int i = dc - t; if (i >= 0 && i < 4) y[i][e2] = y[i][e2] + w[dr * 3 + t][e2] * xv; } }
#pragma unroll
        for (int i = 0; i < 4; ++i) { v4u o;
#pragma unroll
            for (int e2 = 0; e2 < 4; ++e2) { const f32x2 gte = bf2f2(gv[i][e2]); const f32x2 yy = y[i][e2];
                f32x2 ex; ex.x = __builtin_amdgcn_exp2f(yy.x * -1.44269504f); ex.y = __builtin_amdgcn_exp2f(yy.y * -1.44269504f);
                const f32x2 den = ex + 1.0f; f32x2 rc; rc.x = __builtin_amdgcn_rcpf(den.x); rc.y = __builtin_amdgcn_rcpf(den.y);
                const f32x2 res = yy * rc * gte;
                o[e2] = pk2(res.x, res.y); }
            *(v4u*)(Ug + (tok0 + c0 + i) * DFF + ch) = o; }
    }
}

#define XB_TMO      128
#define XB_XCNT(j)  (256  + 64 * (j))
#define XB_XSUB(j)  (1280 + 64 * (j))
#define XB_XGEN(j)  (2304 + 64 * (j))
#define XB_TOP      3328
#define XB_TOPGEN   3392
#define XCD_BAR_WORDS 3456
#define XB_SPIN_CAP (1u << 18)

__device__ __forceinline__ unsigned xb_ld(unsigned* p)              { return __hip_atomic_load(p, __ATOMIC_RELAXED, __HIP_MEMORY_SCOPE_AGENT); }
__device__ __forceinline__ unsigned xb_add(unsigned* p, unsigned v) { return __hip_atomic_fetch_add(p, v, __ATOMIC_RELAXED, __HIP_MEMORY_SCOPE_AGENT); }
__device__ __forceinline__ unsigned xb_xcc_id() { return (unsigned)__builtin_amdgcn_s_getreg((3 << 11) | 20) & 0xFu; }
#define XB_SPIN(cond, bar) do { unsigned _sp = 0; while (cond) { __builtin_amdgcn_s_sleep(1); \
    if ((++_sp & 255u) == 0u) { if (xb_ld(&(bar)[XB_TMO])) break; if (_sp > XB_SPIN_CAP) { atomicAdd(&(bar)[XB_TMO], 1u); break; } } } } while (0)

struct XcdBarrier {
    unsigned* bar; unsigned x;
    volatile LAS unsigned* st;
};

__device__ __forceinline__ XcdBarrier xcd_barrier_post(unsigned* bar, volatile LAS unsigned* st) {
    XcdBarrier b; b.bar = bar; b.x = xb_xcc_id(); b.st = st;
    if (threadIdx.x == 0) (void)xb_add(&bar[XB_XCNT(b.x)], 1u);
    return b;
}
__device__ __forceinline__ void xcd_barrier_complete(unsigned* bar, unsigned x, unsigned& nloc, unsigned& nx) {
    const unsigned G = gridDim.x * gridDim.y * gridDim.z;
    unsigned sum, cnt, mine, sp = 0u;
    for (;;) {
        sum = 0u; cnt = 0u; mine = 0u;
#pragma unroll
        for (unsigned j = 0; j < 16; ++j) { const unsigned c = xb_ld(&bar[XB_XCNT(j)]); sum += c; cnt += (c > 0u) ? 1u : 0u; mine = (j == x) ? c : mine; }
        if (sum == G) break;
        __builtin_amdgcn_s_sleep(1);
        if ((++sp & 255u) == 0u) { if (xb_ld(&bar[XB_TMO])) break; if (sp > XB_SPIN_CAP) { atomicAdd(&bar[XB_TMO], 1u); break; } }
    }
    nloc = mine > 0u ? mine : 1u; nx = cnt > 0u ? cnt : 1u;
}

__device__ __forceinline__ void xcd_barrier(const XcdBarrier& b) {
    asm volatile("s_waitcnt vmcnt(0)" ::: "memory");
    __syncthreads();
    if (threadIdx.x == 0) {
        unsigned* bar = b.bar;
        __builtin_amdgcn_s_waitcnt(0);
        unsigned nloc = b.st[0], nx = b.st[1];
        if (nloc == 0u) { xcd_barrier_complete(bar, b.x, nloc, nx); b.st[0] = nloc; b.st[1] = nx; }
        const unsigned old = xb_add(&bar[XB_XSUB(b.x)], 1u);
        const unsigned gen = old / nloc;
        if (old + 1u == (gen + 1u) * nloc) {
            __builtin_amdgcn_fence(__ATOMIC_RELEASE, "agent");
            asm volatile("s_waitcnt vmcnt(0)" ::: "memory");
            const unsigned og = xb_add(&bar[XB_TOP], 1u);
            const unsigned tg = og / nx;
            if (og + 1u == (tg + 1u) * nx) xb_add(&bar[XB_TOPGEN], 1u);
            else XB_SPIN(xb_ld(&bar[XB_TOPGEN]) == tg, bar);
            __builtin_amdgcn_fence(__ATOMIC_ACQUIRE, "agent");
            xb_add(&bar[XB_XGEN(b.x)], 1u);
            asm volatile("s_waitcnt vmcnt(0)" ::: "memory");
        } else {
            XB_SPIN(xb_ld(&bar[XB_XGEN(b.x)]) == gen, bar);
            __builtin_amdgcn_fence(__ATOMIC_ACQUIRE, "agent");
            asm volatile("s_waitcnt vmcnt(0)" ::: "memory");
        }
    }
    __syncthreads();
}


__global__ void __launch_bounds__(NTHR, 2) fwd_mega(Args A) {
    extern __shared__ __attribute__((aligned(16))) unsigned char lds_raw[];
    LAS unsigned char* lds = (LAS unsigned char*)lds_raw;
    cg::grid_group grid = cg::this_grid();
#define PH_IDS() int tid = threadIdx.x; asm volatile("" : "+v"(tid)); const int lane = tid & 63, wave = __builtin_amdgcn_readfirstlane(tid >> 6); (void)lane; (void)wave
    unsigned char* ws = A.ws;
    const int G = gridDim.x, c = blockIdx.x;
    const bool sc_embed = (G * NTHR * 16 == (NTOK / 2) * 64);

    volatile LAS unsigned* bst = (volatile LAS unsigned*)(lds + LDS_STAGE);
    if (threadIdx.x < 16) bst[threadIdx.x] = 0u;
    unsigned* barw = (unsigned*)(ws + WS_BAR);
    __syncthreads();
    XcdBarrier bar = xcd_barrier_post(barw, bst);
    if (A.out == nullptr) grid.sync();
    { PH_IDS(); phase_mod(A, lds, tid); }
    xcd_barrier(bar);
#define SEAM() xcd_barrier(bar)
    if (__builtin_amdgcn_readfirstlane(threadIdx.x >> 6) & 1) { { PH_IDS(); phase_wprep(A, lds, tid, lane, wave); } { PH_IDS(); phase_rows1(A, lane, wave); } }
    else                                                      { { PH_IDS(); phase_rows1(A, lane, wave); } { PH_IDS(); phase_wprep(A, lds, tid, lane, wave); } }
    SEAM();
    {
        pg8::Gemm g{(const bf16*)(ws + WS_A), (const bf16*)(ws + WS_WIN), MROWS, DINP, D}; pg8::StaticOrder S; S.init(MROWS, DINP, G, c);
        pg8::EpiStore E{(bf16*)(ws + WS_B), DINP, 0, 0};
        pg8::gemm_phase<pg8::EpiStore, pg8::StaticOrder, false, true>(lds, g, S, E);
    }
    SEAM();
    { PH_IDS(); phase_g1(A, lds, tid, lane, wave); }
    SEAM();
    { PH_IDS(); phase_g2(A, tid); }
    if (!sc_embed) { PH_IDS(); phase_sconv(A, tid); }
    SEAM();
    { PH_IDS(); phase_g3(A, lds, tid, lane, wave, sc_embed); }
    SEAM();
    {
        pg8::Gemm g{(const bf16*)(ws + WS_A), (const bf16*)(ws + WS_WOUT), NTOK, D, D}; pg8::StaticOrder S; S.init(NTOK, D, G, c);
        pg8::EpiStore E{(bf16*)(ws + WS_B), D, 0, 0};
        pg8::gemm_phase<pg8::EpiStore, pg8::StaticOrder, false, true>(lds, g, S, E);
    }
    SEAM();
    { PH_IDS(); phase_rows2(A, lane, wave); }
    SEAM();
    {
        pg8::Gemm g{(const bf16*)(ws + WS_A), (const bf16*)(ws + WS_WUP), NTOK, 2 * DFF, D}; pg8::StaticOrder S; S.init(NTOK, 2 * DFF, G, c);
        pg8::EpiStore E{(bf16*)(ws + WS_B), DFF, DFF, (size_t)NTOK * DFF};
        pg8::gemm_phase<pg8::EpiStore, pg8::StaticOrder, false, true>(lds, g, S, E);
    }
    SEAM();
    { PH_IDS(); phase_conv(A, tid); }
    SEAM();
    {
        pg8::Gemm g{(const bf16*)(ws + WS_UG), (const bf16*)(ws + WS_WDN), NTOK, D, DFF}; pg8::StaticOrder S; S.init(NTOK, D, G, c);
        pg8::EpiStore E{(bf16*)(ws + WS_A), D, 0, 0};
        pg8::gemm_phase<pg8::EpiStore, pg8::StaticOrder, false, true>(lds, g, S, E);
    }
    SEAM();
    { PH_IDS(); phase_rows3(A, lane, wave); }
}

extern "C" void kernel_launch(void* const* d_in, const int* in_sizes, int n_in, void* d_out, int out_size, void* d_ws, size_t ws_size, hipStream_t stream) {
    static int grid = 0;
    if (grid == 0) {
        if (n_in != 23 || ws_size < WS_END) { fprintf(stderr, "kernel_launch: unexpected n_in %d or ws_size %zu (< %zu)\n", n_in, ws_size, (size_t)WS_END); grid = -1; return; }
        int dev = 0, cus = 0, per_cu = 0;
        (void)hipGetDevice(&dev); (void)hipDeviceGetAttribute(&cus, hipDeviceAttributeMultiprocessorCount, dev);
        (void)hipFuncSetAttribute((const void*)fwd_mega, hipFuncAttributeMaxDynamicSharedMemorySize, LDS_BYTES);
        (void)hipOccupancyMaxActiveBlocksPerMultiprocessor(&per_cu, (const void*)fwd_mega, NTHR, LDS_BYTES);
        (void)per_cu;
        grid = cus;
        (void)hipGetLastError();
    }
    if (grid < 0) return;
    Args a{};
    for (int i = 0; i < 23; ++i) a.in[i] = (const float*)d_in[i];
    a.out = (float*)d_out; a.ws = (unsigned char*)d_ws;
    (void)hipMemsetAsync((unsigned char*)d_ws + WS_BAR, 0, XCD_BAR_WORDS * sizeof(unsigned), stream);
    void* args[] = {&a};
    hipError_t e = hipLaunchCooperativeKernel((const void*)fwd_mega, dim3(grid), dim3(NTHR), args, LDS_BYTES, stream);
    if (e != hipSuccess) fprintf(stderr, "cooperative launch failed: %s (grid %d)\n", hipGetErrorString(e), grid);
}
```
